# Optimizing an MI355X kernel written in HIP

```python
import math
import jax
import jax.numpy as jnp
from jax import lax
import numpy as np

D_MODEL = 1024
BATCH = 1
SEQ = 16384
DEPTH = 2
DEC_BATCH = 32
DEC_SEQ = 4
PAST_LEN = 16384
PAGE_SIZE = 128

N_EVEN = (DEPTH + 1) // 2
N_ODD = DEPTH // 2
MLP_HIDDEN = 4 * D_MODEL
C_CONV = D_MODEL // 2
CONV_WIDTH = 31
NSA_HEAD_DIM = 64
NSA_HEADS = (D_MODEL // 2) // NSA_HEAD_DIM
NSA_KV_HEADS = NSA_HEADS // 4
NSA_GROUP = NSA_HEADS // NSA_KV_HEADS
CMP_STRIDE = 16
CMP_LEN = 2 * CMP_STRIDE
CMP_HIDDEN = 2 * NSA_HEAD_DIM
SEL_BLOCK = 64
TOP_N = 16
WINDOW = 512
Q_BLOCK = 128
REL_BUCKETS = 32
REL_EXACT = REL_BUCKETS // 2
REL_MAX_DIST = 128
HG_DK = 128
HG_HEADS = D_MODEL // HG_DK
HG_DV = D_MODEL // HG_HEADS
HG_CHUNK = 64
RMS_EPS = 1e-6
NEG_INF = -1e30
BIG = 1e9
O_Q = 2 * C_CONV
O_KV = O_Q + NSA_HEADS * NSA_HEAD_DIM
O_GATE = O_KV + 3 * 2 * NSA_KV_HEADS * NSA_HEAD_DIM
ATT_IN_COLS = O_GATE + 3 * NSA_HEADS
ATT_OUT_ROWS = C_CONV + NSA_HEADS * NSA_HEAD_DIM

kernel_name = 'hybrid_conformer_nsa_hgrn2_step'


def rms_norm(x, g):
    xf = x.astype(jnp.float32)
    y = xf * lax.rsqrt(jnp.mean(xf * xf, axis=-1, keepdims=True) + RMS_EPS) * g.astype(jnp.float32)
    return y.astype(x.dtype)


def layer_norm(x, g, b):
    xf = x.astype(jnp.float32)
    mu = jnp.mean(xf, axis=-1, keepdims=True)
    var = jnp.mean(jnp.square(xf - mu), axis=-1, keepdims=True)
    return ((xf - mu) * lax.rsqrt(var + RMS_EPS) * g.astype(jnp.float32) + b.astype(jnp.float32)).astype(x.dtype)


def masked_softmax(logits, mask):
    logits = jnp.where(mask, logits.astype(jnp.float32), NEG_INF)
    m = jnp.max(logits, axis=-1, keepdims=True)
    e = jnp.where(mask, jnp.exp(logits - m), 0.0)
    return e / jnp.maximum(jnp.sum(e, axis=-1, keepdims=True), 1e-30)


def t5_bucket(dist):
    n = jnp.maximum(dist, 0)
    large = REL_EXACT + (jnp.log(jnp.maximum(n, 1).astype(jnp.float32) / REL_EXACT)
                         / math.log(REL_MAX_DIST / REL_EXACT) * (REL_BUCKETS - REL_EXACT)).astype(jnp.int32)
    return jnp.where(n < REL_EXACT, n, jnp.minimum(large, REL_BUCKETS - 1))


def sq_relu_mlp(h, w_up, w_down):
    return jnp.square(jax.nn.relu(h @ w_up)) @ w_down


def conformer_conv(u, state, w, b, ln_g, ln_b):
    a, gt = jnp.split(u, 2, axis=-1)
    glu = a * jax.nn.sigmoid(gt)
    xin = jnp.concatenate([state.astype(glu.dtype), glu], axis=1)
    y = lax.conv_general_dilated(xin, w[:, None, :].astype(xin.dtype), (1,), 'VALID',
                                 dimension_numbers=('NWC', 'WIO', 'NWC'),
                                 feature_group_count=C_CONV) + b
    y = jax.nn.silu(layer_norm(y, ln_g, ln_b))
    return y, xin[:, xin.shape[1] - (CONV_WIDTH - 1):]


def compress_rows(rows, pe, w1, b1, w2):
    B, T = rows.shape[:2]
    nch = T // CMP_STRIDE
    ch = rows[:, :nch * CMP_STRIDE].reshape(B, nch, CMP_STRIDE, NSA_KV_HEADS, NSA_HEAD_DIM)
    h_first = jnp.einsum('bcshd,sdf->bchf', ch + pe[:CMP_STRIDE, None, :], w1[:CMP_STRIDE])
    h_second = jnp.einsum('bcshd,sdf->bchf', ch + pe[CMP_STRIDE:, None, :], w1[CMP_STRIDE:])
    hid = jax.nn.gelu(h_first[:, :-1] + h_second[:, 1:] + b1)
    return jnp.einsum('bchf,fd->bchd', hid, w2)


def selection_scores(imp, ns):
    nc = imp.shape[-1]
    ratio = SEL_BLOCK // CMP_STRIDE
    span = CMP_LEN // CMP_STRIDE
    offs = np.array([m - n for m in range(ratio) for n in range(span)], dtype=np.int32)
    idx = ratio * np.arange(ns, dtype=np.int32)[:, None] + offs[None, :]
    valid = (idx >= 0) & (idx < nc)
    got = jnp.take(imp, np.clip(idx, 0, nc - 1).reshape(-1), axis=-1).reshape(imp.shape[:-1] + idx.shape)
    return jnp.sum(jnp.where(valid, got, 0.0), axis=-1)


def gather_blocks(blocks, idx):
    per_head = jax.vmap(lambda bh, ih: bh[ih], in_axes=(0, 1), out_axes=1)
    return jax.vmap(per_head)(blocks, idx)


def nsa_block(q, gates, q_pos, kc, vc, c_end, ks_blocks, vs_blocks, kw, vw, kw_pos, rel_table):
    B, Q = q.shape[:2]
    scale = NSA_HEAD_DIM ** -0.5
    table_hg = rel_table.astype(jnp.float32).reshape(REL_BUCKETS, NSA_KV_HEADS, NSA_GROUP)
    dist_c = q_pos[:, None] - c_end[None, :]
    bias_c = table_hg[t5_bucket(dist_c)].transpose(0, 2, 3, 1)
    logit_c = jnp.einsum('bqhgd,bnhd->bqhgn', q, kc).astype(jnp.float32) * scale + bias_c
    p_c = masked_softmax(logit_c, (dist_c >= 0)[:, None, None, :])
    o_c = jnp.einsum('bqhgn,bnhd->bqhgd', p_c, vc.astype(jnp.float32))
    ns = ks_blocks.shape[2]
    s = selection_scores(jnp.sum(p_c, axis=3), ns)
    j = jnp.arange(ns, dtype=jnp.int32)[None, :]
    qp = q_pos[:, None]
    cur = qp // SEL_BLOCK
    forced = (j == 0) | (j == cur) | (j == cur - 1)
    valid = j * SEL_BLOCK <= qp
    s = jnp.where(forced[None, :, None, :], BIG, s)
    s = jnp.where(valid[None, :, None, :], s, -BIG)
    _, idx = lax.top_k(s, min(TOP_N, ns))
    kg = gather_blocks(ks_blocks, idx)
    vg = gather_blocks(vs_blocks, idx)
    n_sel = idx.shape[-1] * SEL_BLOCK
    key_pos = idx[..., None] * SEL_BLOCK + jnp.arange(SEL_BLOCK, dtype=jnp.int32)
    dist_s = q_pos[None, :, None, None, None] - key_pos
    bias_s = table_hg[t5_bucket(dist_s), jnp.arange(NSA_KV_HEADS)[None, None, :, None, None]]
    bias_s = bias_s.transpose(0, 1, 2, 5, 3, 4).reshape(B, Q, NSA_KV_HEADS, NSA_GROUP, n_sel)
    logit_s = jnp.einsum('bqhgd,bqhnsd->bqhgns', q, kg).astype(jnp.float32).reshape(
        B, Q, NSA_KV_HEADS, NSA_GROUP, n_sel) * scale + bias_s
    p_s = masked_softmax(logit_s, (dist_s >= 0).reshape(B, Q, NSA_KV_HEADS, 1, n_sel))
    o_s = jnp.einsum('bqhgn,bqhnd->bqhgd', p_s,
                     vg.reshape(B, Q, NSA_KV_HEADS, n_sel, NSA_HEAD_DIM).astype(jnp.float32))
    dist_w = q_pos[:, None] - kw_pos[None, :]
    mask_w = (dist_w >= 0) & (dist_w <= WINDOW) & (kw_pos[None, :] >= 0)
    bias_w = table_hg[t5_bucket(dist_w)].transpose(0, 2, 3, 1)
    logit_w = jnp.einsum('bqhgd,bkhd->bqhgk', q, kw).astype(jnp.float32) * scale + bias_w
    p_w = masked_softmax(logit_w, mask_w[:, None, None, :])
    o_w = jnp.einsum('bqhgk,bkhd->bqhgd', p_w, vw.astype(jnp.float32))
    g = gates.astype(jnp.float32)
    return (g[..., 0:1] * o_c + g[..., 1:2] * o_s + g[..., 2:3] * o_w).astype(q.dtype)


def nsa_attend(q, gates, pos0, kc, vc, c_end, ks_blocks, vs_blocks, kw_all, rel_table):
    B, T = q.shape[:2]
    qb = min(Q_BLOCK, T)
    nb = T // qb
    q_blocks = q.reshape((B, nb, qb) + q.shape[2:]).swapaxes(0, 1)
    g_blocks = gates.reshape((B, nb, qb) + gates.shape[2:]).swapaxes(0, 1)

    def one_block(args):
        i, qi, gi = args
        start = i * qb
        q_pos = pos0 + start + jnp.arange(qb, dtype=jnp.int32)
        kw = lax.dynamic_slice_in_dim(kw_all, start, WINDOW + qb, axis=1)
        kw_pos = pos0 - WINDOW + start + jnp.arange(WINDOW + qb, dtype=jnp.int32)
        return nsa_block(qi, gi, q_pos, kc, vc, c_end, ks_blocks, vs_blocks,
                         kw[:, :, 0], kw[:, :, 1], kw_pos, rel_table)

    o = lax.map(one_block, (jnp.arange(nb, dtype=jnp.int32), q_blocks, g_blocks))
    return o.swapaxes(0, 1).reshape(q.shape)


def even_mixer(h, past_kv, win_buf, conv_state, rel_table, w_in, w_out, q_g, k_g,
               pe, w1, b1, w2, conv_w, conv_b, ln_g, ln_b):
    B, T, _ = h.shape
    pos0 = past_kv.shape[1]
    proj = h @ w_in
    conv_y, conv_new = conformer_conv(proj[..., :O_Q], conv_state, conv_w, conv_b, ln_g, ln_b)
    q = rms_norm(proj[..., O_Q:O_KV].reshape(B, T, NSA_KV_HEADS, NSA_GROUP, NSA_HEAD_DIM), q_g)
    kv = proj[..., O_KV:O_GATE].reshape(B, T, 3, 2, NSA_KV_HEADS, NSA_HEAD_DIM)
    gates = jax.nn.sigmoid(proj[..., O_GATE:].astype(jnp.float32)).reshape(B, T, NSA_KV_HEADS, NSA_GROUP, 3)
    kv_new = jnp.stack([kv[:, :, 0, 0], kv[:, :, 0, 1], rms_norm(kv[:, :, 1, 0], k_g[1]), kv[:, :, 1, 1]], axis=2)
    kv_all = jnp.concatenate([past_kv.astype(kv_new.dtype), kv_new], axis=1)
    t_all = pos0 + T
    kc = rms_norm(compress_rows(kv_all[:, :, 0], pe[0], w1[0], b1[0], w2[0]), k_g[0])
    vc = compress_rows(kv_all[:, :, 1], pe[1], w1[1], b1[1], w2[1])
    c_end = jnp.arange(kc.shape[1], dtype=jnp.int32) * CMP_STRIDE + (CMP_LEN - 1)
    ns = -(-t_all // SEL_BLOCK)
    sel = jnp.pad(kv_all[:, :, 2:], ((0, 0), (0, ns * SEL_BLOCK - t_all), (0, 0), (0, 0), (0, 0)))
    sel = sel.reshape(B, ns, SEL_BLOCK, 2, NSA_KV_HEADS, NSA_HEAD_DIM).transpose(3, 0, 4, 1, 2, 5)
    win_new = jnp.stack([rms_norm(kv[:, :, 2, 0], k_g[2]), kv[:, :, 2, 1]], axis=2)
    win_all = jnp.concatenate([win_buf.astype(win_new.dtype), win_new], axis=1)
    win_keep = win_all[:, win_all.shape[1] - min(WINDOW, win_all.shape[1]):]
    kw_all = jnp.pad(win_all, ((0, 0), (WINDOW - win_buf.shape[1], 0), (0, 0), (0, 0), (0, 0)))
    o = nsa_attend(q, gates, pos0, kc, vc, c_end, sel[0], sel[1], kw_all, rel_table)
    mix = jnp.concatenate([conv_y, o.reshape(B, T, NSA_HEADS * NSA_HEAD_DIM)], axis=-1) @ w_out
    return mix, kv_new, win_keep, conv_new


def hgrn2_scan(q, k, v, log_f, s0):
    B, T, H, DK = q.shape
    DV = v.shape[-1]
    c = min(HG_CHUNK, T)
    n = -(-T // c)
    pad = n * c - T

    def blocks(a):
        a = jnp.pad(a.astype(jnp.float32), ((0, 0), (0, pad), (0, 0), (0, 0)))
        return a.reshape(B, n, c, H, a.shape[-1]).transpose(1, 0, 3, 2, 4)

    tri = jnp.tril(jnp.ones((c, c), dtype=bool))

    def step(s, inp):
        qc, kc, vc, lf = inp
        b = jnp.cumsum(lf, axis=2)
        decay = jnp.exp(jnp.where(tri[:, :, None], b[:, :, :, None, :] - b[:, :, None, :, :], -jnp.inf))
        attn = jnp.einsum('bhtd,bhsd,bhtsd->bhts', qc, kc, decay)
        o = jnp.einsum('bhts,bhsv->bhtv', attn, vc) + jnp.einsum('bhtd,bhdv->bhtv', qc * jnp.exp(b), s)
        b_last = b[:, :, -1:, :]
        s = jnp.exp(b_last[:, :, 0, :, None]) * s + jnp.einsum('bhsd,bhsv->bhdv', kc * jnp.exp(b_last - b), vc)
        return s, o

    s, o = lax.scan(step, s0.astype(jnp.float32), (blocks(q), blocks(k), blocks(v), blocks(log_f)))
    o = o.transpose(1, 0, 3, 2, 4).reshape(B, n * c, H, DV)[:, :T]
    return o.astype(v.dtype), s.astype(s0.dtype)


def hgrn2_mixer(h, s0, layer, w_in, w_out, lb_logits, norm_g):
    B, T, _ = h.shape
    q, fz, i, g = jnp.split(h @ w_in, 4, axis=-1)
    cum = jnp.cumsum(jax.nn.softmax(lb_logits.astype(jnp.float32), axis=0), axis=0)
    lb = cum[layer] - cum[0]
    f = lb + (1.0 - lb) * jax.nn.sigmoid(fz.astype(jnp.float32))

    def heads(a):
        return a.reshape(B, T, HG_HEADS, -1)

    o, s_new = hgrn2_scan(heads(q), heads(1.0 - f), heads(i), heads(jnp.log(f)), s0)
    o = rms_norm(o, norm_g) * jax.nn.silu(heads(g))
    return o.reshape(B, T, D_MODEL) @ w_out, s_new


def trunk(x, past_kv, win_buf, conv_state, hg_state, rel_bias_table, norm_mix_g, norm_mlp_g,
          w_mlp_up, w_mlp_down, att_w_in, att_w_out, q_norm_g, k_norm_g, cmp_pe, cmp_w1, cmp_b1,
          cmp_w2, conv_w, conv_b, conv_ln_g, conv_ln_b, hg_w_in, hg_w_out, hg_lb_logits, hg_norm_g):
    kv_rows, win_rows, conv_rows, hg_rows = [], [], [], []
    for layer in range(DEPTH):
        h = rms_norm(x, norm_mix_g[layer])
        if layer % 2 == 0:
            e = layer // 2
            mix, kv_new, win_new, conv_new = even_mixer(
                h, past_kv[e], win_buf[e], conv_state[e], rel_bias_table, att_w_in[e], att_w_out[e],
                q_norm_g[e], k_norm_g[e], cmp_pe[e], cmp_w1[e], cmp_b1[e], cmp_w2[e],
                conv_w[e], conv_b[e], conv_ln_g[e], conv_ln_b[e])
            kv_rows.append(kv_new)
            win_rows.append(win_new)
            conv_rows.append(conv_new)
        else:
            o = layer // 2
            mix, s_new = hgrn2_mixer(h, hg_state[o], layer, hg_w_in[o], hg_w_out[o], hg_lb_logits, hg_norm_g[o])
            hg_rows.append(s_new)
        x = x + mix
        x = x + sq_relu_mlp(rms_norm(x, norm_mlp_g[layer]), w_mlp_up[layer], w_mlp_down[layer])
    return (x, jnp.stack(kv_rows), jnp.stack(win_rows), jnp.stack(conv_rows), jnp.stack(hg_rows))


def setup_inputs(seed: int = 0) -> dict:
    key = jax.random.key(seed)
    ks = jax.random.split(key, 28)
    n_pages = PAST_LEN // PAGE_SIZE
    n_pool = (DEC_BATCH * n_pages * 5) // 4
    win_rows = min(WINDOW, PAST_LEN)

    def nrm(k, shape, scale=1.0):
        return jax.random.normal(k, shape, jnp.float32) * scale

    def gain(k, shape):
        return 1.0 + nrm(k, shape, 0.05)

    page_table = jax.random.permutation(ks[3], n_pool)[: DEC_BATCH * n_pages].reshape(
        DEC_BATCH, n_pages).astype(jnp.int32)
    return {
        'x_prompt': nrm(ks[0], (BATCH, SEQ, D_MODEL)),
        'x_sample': nrm(ks[1], (DEC_BATCH, DEC_SEQ, D_MODEL)),
        'cache_nsa_kv': nrm(ks[2], (N_EVEN, n_pool, PAGE_SIZE, 4, NSA_KV_HEADS, NSA_HEAD_DIM)),
        'page_table': page_table,
        'state_nsa_win': nrm(ks[4], (N_EVEN, DEC_BATCH, win_rows, 2, NSA_KV_HEADS, NSA_HEAD_DIM)),
        'state_conv': nrm(ks[5], (N_EVEN, DEC_BATCH, CONV_WIDTH - 1, C_CONV)),
        'state_hgrn': nrm(ks[6], (N_ODD, DEC_BATCH, HG_HEADS, HG_DK, HG_DV), 0.5),
        'rel_bias_table': nrm(ks[7], (REL_BUCKETS, NSA_HEADS), 0.5),
        'norm_mix_g': gain(ks[8], (DEPTH, D_MODEL)),
        'norm_mlp_g': gain(ks[9], (DEPTH, D_MODEL)),
        'w_mlp_up': nrm(ks[10], (DEPTH, D_MODEL, MLP_HIDDEN), D_MODEL ** -0.5),
        'w_mlp_down': nrm(ks[11], (DEPTH, MLP_HIDDEN, D_MODEL), MLP_HIDDEN ** -0.5),
        'att_w_in': nrm(ks[12], (N_EVEN, D_MODEL, ATT_IN_COLS), D_MODEL ** -0.5),
        'att_w_out': nrm(ks[13], (N_EVEN, ATT_OUT_ROWS, D_MODEL), ATT_OUT_ROWS ** -0.5),
        'q_norm_g': gain(ks[14], (N_EVEN, NSA_HEAD_DIM)),
        'k_norm_g': gain(ks[15], (N_EVEN, 3, NSA_HEAD_DIM)),
        'cmp_pe': nrm(ks[16], (N_EVEN, 2, CMP_LEN, NSA_HEAD_DIM), 0.1),
        'cmp_w1': nrm(ks[17], (N_EVEN, 2, CMP_LEN, NSA_HEAD_DIM, CMP_HIDDEN), (CMP_LEN * NSA_HEAD_DIM) ** -0.5),
        'cmp_b1': nrm(ks[18], (N_EVEN, 2, CMP_HIDDEN), 0.01),
        'cmp_w2': nrm(ks[19], (N_EVEN, 2, CMP_HIDDEN, NSA_HEAD_DIM), CMP_HIDDEN ** -0.5),
        'conv_w': nrm(ks[20], (N_EVEN, CONV_WIDTH, C_CONV), CONV_WIDTH ** -0.5),
        'conv_b': nrm(ks[21], (N_EVEN, C_CONV), 0.01),
        'conv_ln_g': gain(ks[22], (N_EVEN, C_CONV)),
        'conv_ln_b': nrm(ks[23], (N_EVEN, C_CONV), 0.01),
        'hg_w_in': nrm(ks[24], (N_ODD, D_MODEL, 4 * D_MODEL), D_MODEL ** -0.5),
        'hg_w_out': nrm(ks[25], (N_ODD, D_MODEL, D_MODEL), D_MODEL ** -0.5),
        'hg_lb_logits': nrm(ks[26], (DEPTH, D_MODEL), 0.5),
        'hg_norm_g': gain(ks[27], (N_ODD, HG_DV)),
    }


def reference(x_prompt, x_sample, cache_nsa_kv, page_table, state_nsa_win, state_conv, state_hgrn,
              rel_bias_table, norm_mix_g, norm_mlp_g, w_mlp_up, w_mlp_down, att_w_in, att_w_out,
              q_norm_g, k_norm_g, cmp_pe, cmp_w1, cmp_b1, cmp_w2, conv_w, conv_b, conv_ln_g, conv_ln_b,
              hg_w_in, hg_w_out, hg_lb_logits, hg_norm_g):
    past_len = page_table.shape[1] * cache_nsa_kv.shape[2]
    db = x_sample.shape[0]
    b = x_prompt.shape[0]
    dt = x_prompt.dtype
    past_s = cache_nsa_kv[:, page_table].reshape(N_EVEN, db, past_len, 4, NSA_KV_HEADS, NSA_HEAD_DIM)
    y_prompt, kv_p, win_p, conv_p, hg_p = trunk(
        x_prompt,
        jnp.zeros((N_EVEN, b, 0, 4, NSA_KV_HEADS, NSA_HEAD_DIM), dt),
        jnp.zeros((N_EVEN, b, 0, 2, NSA_KV_HEADS, NSA_HEAD_DIM), dt),
        jnp.zeros((N_EVEN, b, CONV_WIDTH - 1, C_CONV), dt),
        jnp.zeros((N_ODD, b, HG_HEADS, HG_DK, HG_DV), dt),
        rel_bias_table, norm_mix_g, norm_mlp_g, w_mlp_up, w_mlp_down, att_w_in, att_w_out,
        q_norm_g, k_norm_g, cmp_pe, cmp_w1, cmp_b1, cmp_w2, conv_w, conv_b, conv_ln_g, conv_ln_b,
        hg_w_in, hg_w_out, hg_lb_logits, hg_norm_g)
    y_sample, kv_s, win_s, conv_s, hg_s = trunk(
        x_sample, past_s, state_nsa_win, state_conv, state_hgrn,
        rel_bias_table, norm_mix_g, norm_mlp_g, w_mlp_up, w_mlp_down, att_w_in, att_w_out,
        q_norm_g, k_norm_g, cmp_pe, cmp_w1, cmp_b1, cmp_w2, conv_w, conv_b, conv_ln_g, conv_ln_b,
        hg_w_in, hg_w_out, hg_lb_logits, hg_norm_g)
    return (y_prompt, y_sample, kv_p, kv_s, win_p, win_s, conv_p, conv_s, hg_p, hg_s)
```

```cpp
#include <hip/hip_runtime.h>
#include <stdint.h>
#include <stdio.h>

#define GAS __attribute__((address_space(1)))
#define LAS __attribute__((address_space(3)))
typedef unsigned short bf16_t;
typedef unsigned v4u __attribute__((ext_vector_type(4)));
typedef unsigned v2u __attribute__((ext_vector_type(2)));
typedef float f32x4 __attribute__((ext_vector_type(4)));
#define LDS_WAIT() asm volatile("s_waitcnt lgkmcnt(0)" ::: "memory")
#define VM_WAIT() asm volatile("s_waitcnt vmcnt(0)" ::: "memory")
__device__ __forceinline__ float bf2f(bf16_t b) { return __uint_as_float(((unsigned)b) << 16); }
__device__ __forceinline__ unsigned f2bf(float f) { unsigned u = __builtin_bit_cast(unsigned, f); return (u + 0x7fffu + ((u >> 16) & 1u)) >> 16; }
__device__ __forceinline__ unsigned pk2(float lo, float hi) { return f2bf(lo) | (f2bf(hi) << 16); }
__device__ __forceinline__ float sigmoidf_(float x) { return 1.f / (1.f + __expf(-x)); }
__device__ __forceinline__ float wave_sum(float v) {
#pragma unroll
    for (int o = 1; o < 64; o <<= 1) v += __shfl_xor(v, o);
    return v;
}
__device__ __forceinline__ float wave_max(float v) {
#pragma unroll
    for (int o = 1; o < 64; o <<= 1) v = fmaxf(v, __shfl_xor(v, o));
    return v;
}

constexpr int D = 1024, TP = 16384, SBATCH = 32, STOK = 4, SR = SBATCH * STOK, MR = TP + SR;
constexpr int PAST = 16384, NPAGES = 128;
constexpr int FF = 4096, CC = 512, CWID = 31;
constexpr int NIN = 2328, NINP = 2560;
constexpr int NCMP = 1023;
constexpr int CMPROWS = 66 * 1024;
constexpr float EPS = 1e-6f;
constexpr size_t OFF_YP = 0, OFF_YS = 16777216, OFF_KVP = 16908288, OFF_KVS = 25296896, OFF_WINP = 25362432, OFF_WINS = 25493504,
                 OFF_CONVP = 29687808, OFF_CONVS = 29703168, OFF_HGP = 30194688, OFF_HGS = 30325760, OUT_TOTAL = 34520064;

__device__ __forceinline__ float row_r(const float* ssp, int row) {
    const f32x4* p = (const f32x4*)(ssp + (size_t)row * 16);
    const f32x4 a = p[0], b = p[1], c = p[2], d = p[3];
    const float s = ((a.x + a.y) + (a.z + a.w)) + ((b.x + b.y) + (b.z + b.w)) + ((c.x + c.y) + (c.z + c.w)) + ((d.x + d.y) + (d.z + d.w));
    return rsqrtf(s * (1.f / D) + EPS);
}
__device__ __forceinline__ int otid() { int t = threadIdx.x; asm volatile("" : "+v"(t)); return t; }
namespace pg8 {
#define PG8_LAS __attribute__((address_space(3)))
typedef unsigned short bf16_t;
typedef short bf16x8 __attribute__((ext_vector_type(8)));
typedef float f32x4 __attribute__((ext_vector_type(4)));
typedef unsigned u32x4 __attribute__((ext_vector_type(4)));
constexpr int BM = 256, BK = 64, HALF = 128, HTB = HALF * BK * 2  , STAGE_BYTES = 8 * HTB, NXCD = 8, WGM = 8;

__host__ __device__ __forceinline__ int lds_byte(int r, int c) { const int st = (r >> 4) * 2 + (c >> 5), rr = r & 15, cc = c & 31, ob = rr * 64 + cc * 2; return st * 1024 + (ob ^ (((ob >> 9) & 1) << 5)); }
__host__ __device__ __forceinline__ void stage_rc(int b, int& R, int& C) { const int st = b / 1024, sb = b % 1024, swz = sb ^ (((sb >> 9) & 1) << 5); R = (st >> 1) * 16 + swz / 64; C = (st & 1) * 32 + (swz % 64) / 2; }
__host__ __device__ __forceinline__ int perm32(int rho) { const int n = rho >> 4, i = rho & 15; return 8 * (i >> 2) + 4 * n + (i & 3); }

struct Unit { int pm, pn, ty; };
struct Gemm { const bf16_t* A; const bf16_t* Bt; int M, N, K; };

struct StaticOrder {
    int nM, nN, nwg, G, c;
    __host__ __device__ void init(int M, int N, int G_, int c_) { nM = M / BM; nN = N / BM; nwg = nM * nN; G = G_; c = c_; }
    __host__ __device__ bool next(int i, Unit& u) const {
        const long L = (long)i * G + c; if (L >= nwg) return false;
        int wgid = (int)L; { const int q = nwg / NXCD, r = nwg % NXCD, xcd = wgid % NXCD, off = wgid / NXCD; wgid = (xcd < r ? xcd * (q + 1) : r * (q + 1) + (xcd - r) * q) + off; }
        const int nig = WGM * nN, gid = wgid / nig, fm = gid * WGM, gsz = (nM - fm) < WGM ? (nM - fm) : WGM;
        u.pm = fm + ((wgid % nig) % gsz); u.pn = (wgid % nig) / gsz; u.ty = 0; return true;
    }
    __device__ __forceinline__ const char* pa(const Gemm& g, const Unit& u, size_t tstep) const { return (const char*)g.A + (size_t)u.pm * tstep; }
    __device__ __forceinline__ const char* pb(const Gemm& g, const Unit& u, size_t tstep) const { return (const char*)g.Bt + (size_t)u.pn * tstep; }
    __device__ __forceinline__ void a_ready(const Unit&) const {}
    __device__ __forceinline__ void done(const Unit&) const {}
};


struct DualOrder {
    StaticOrder S1; int n1, n2, sh, p0, ppk; const char* A2; const char* B2;
    __device__ __forceinline__ bool next(int i, Unit& u) const {
        if (S1.next(i, u)) return true;
        const long L = (long)i * S1.G + S1.c - n1; if (L < 0 || L >= n2) return false;
        const int kv = (int)(L >> sh), p = p0 + (int)(L & ((1 << sh) - 1)); u.pm = kv * ppk + p; u.pn = kv; u.ty = 1; return true;
    }
    __device__ __forceinline__ const char* pa(const Gemm& g, const Unit& u, size_t tstep) const { return u.ty ? A2 + (size_t)u.pm * tstep : (const char*)g.A + (size_t)u.pm * tstep; }
    __device__ __forceinline__ const char* pb(const Gemm& g, const Unit& u, size_t tstep) const { return u.ty ? B2 + (size_t)u.pn * tstep : (const char*)g.Bt + (size_t)u.pn * tstep; }
    __device__ __forceinline__ void a_ready(const Unit&) const {}
    __device__ __forceinline__ void done(const Unit&) const {}
};
__device__ __forceinline__ unsigned cvt_pk_bf16(float lo, float hi) { unsigned r; asm volatile("v_cvt_pk_bf16_f32 %0, %1, %2" : "=v"(r) : "v"(lo), "v"(hi)); return r; }
typedef float f32x2 __attribute__((ext_vector_type(2)));
struct EpiProj {
    static constexpr bool PERM = false, AFTER_DRAIN = false;
    float* proj; const float* ssp;
    __device__ __forceinline__ void operator()(const f32x4 (&acc)[2][2][4][2], const Unit& u, int wr, int wc, int fr, int fq) const {
        const int row0 = u.pm * BM + wr * 64 + fr, col0 = u.pn * BM + wc * 32 + 4 * fq;
#pragma unroll
        for (int ai = 0; ai < 2; ++ai)
#pragma unroll
            for (int m = 0; m < 4; ++m) { const int row = row0 + ai * HALF + m * 16; const float r = row_r(ssp, row);
#pragma unroll
                for (int bj = 0; bj < 2; ++bj)
#pragma unroll
                    for (int n = 0; n < 2; ++n) { const int col = col0 + bj * HALF + n * 16; if (col < NIN) *(f32x4*)(proj + (size_t)row * NIN + col) = acc[ai][bj][m][n] * r; } }
    }
};
struct EpiScale {
    static constexpr bool PERM = false, AFTER_DRAIN = false;
    float* out; const float* ssp; int ld; int pad;
    __device__ __forceinline__ void operator()(const f32x4 (&acc)[2][2][4][2], const Unit& u, int wr, int wc, int fr, int fq) const {
        const int row0 = u.pm * BM + wr * 64 + fr, col0 = u.pn * BM + wc * 32 + 4 * fq;
#pragma unroll
        for (int ai = 0; ai < 2; ++ai)
#pragma unroll
            for (int m = 0; m < 4; ++m) { const int row = row0 + ai * HALF + m * 16; const float r = ssp ? row_r(ssp, row) : 1.f;
#pragma unroll
                for (int bj = 0; bj < 2; ++bj)
#pragma unroll
                    for (int n = 0; n < 2; ++n) { const int col = col0 + bj * HALF + n * 16; *(f32x4*)(out + (size_t)row * ld + col) = acc[ai][bj][m][n] * r; } }
    }
};
struct EpiResid {
    static constexpr bool PERM = false, AFTER_DRAIN = false;
    const float* xin; float* out; bf16_t* xb; float* sspo;
    __device__ __forceinline__ void operator()(const f32x4 (&acc)[2][2][4][2], const Unit& u, int wr, int wc, int fr, int fq) const {
        const int row0 = u.pm * BM + wr * 64 + fr, col0 = u.pn * BM + wc * 32 + 4 * fq;
#pragma unroll
        for (int ai = 0; ai < 2; ++ai)
#pragma unroll
            for (int m = 0; m < 4; ++m) { const int row = row0 + ai * HALF + m * 16; float part = 0.f;
#pragma unroll
                for (int bj = 0; bj < 2; ++bj)
#pragma unroll
                    for (int n = 0; n < 2; ++n) { const int col = col0 + bj * HALF + n * 16; const size_t off = (size_t)row * D + col;
                        const f32x4 o = *(const f32x4*)(xin + off) + acc[ai][bj][m][n];
                        *(f32x4*)(out + off) = o;
                        if (xb) { v2u w; w.x = cvt_pk_bf16(o[0], o[1]); w.y = cvt_pk_bf16(o[2], o[3]); *(v2u*)(xb + off) = w; }
                        part += (o[0] * o[0] + o[1] * o[1]) + (o[2] * o[2] + o[3] * o[3]); }
                part += __shfl_xor(part, 16); part += __shfl_xor(part, 32);
                if (sspo && fq == 0) sspo[(size_t)row * 16 + u.pn * 4 + wc] = part; }
    }
};
struct EpiUp {
    static constexpr bool PERM = true, AFTER_DRAIN = false;
    bf16_t* hid; const float* ssp;
    __device__ __forceinline__ void operator()(const f32x4 (&acc)[2][2][4][2], const Unit& u, int wr, int wc, int fr, int fq) const {
        const int row0 = u.pm * BM + wr * 64 + fr, col0 = u.pn * BM + wc * 32 + 8 * fq;
#pragma unroll
        for (int ai = 0; ai < 2; ++ai)
#pragma unroll
            for (int m = 0; m < 4; ++m) { const int row = row0 + ai * HALF + m * 16; const float r = row_r(ssp, row), r2 = r * r; bf16_t* rowp = hid + (size_t)row * FF + col0;
#pragma unroll
                for (int bj = 0; bj < 2; ++bj) { f32x4 v0 = acc[ai][bj][m][0], v1 = acc[ai][bj][m][1];
#pragma unroll
                    for (int i = 0; i < 4; ++i) { const float a = fmaxf(v0[i], 0.f), b = fmaxf(v1[i], 0.f); v0[i] = a * a * r2; v1[i] = b * b * r2; }
                    u32x4 w; w.x = cvt_pk_bf16(v0[0], v0[1]); w.y = cvt_pk_bf16(v0[2], v0[3]); w.z = cvt_pk_bf16(v1[0], v1[1]); w.w = cvt_pk_bf16(v1[2], v1[3]);
                    *(u32x4*)(rowp + bj * HALF) = w; } }
    }
};

struct EpiCmp {
    static constexpr bool PERM = false, AFTER_DRAIN = false;
    float* out;
    __device__ __forceinline__ void operator()(const f32x4 (&acc)[2][2][4][2], const Unit& u, int wr, int wc, int fr, int fq) const {
        const int row0 = u.pm * BM + wr * 64 + fr, col0 = wc * 32 + 4 * fq;
#pragma unroll
        for (int ai = 0; ai < 2; ++ai)
#pragma unroll
            for (int m = 0; m < 4; ++m) { const int row = row0 + ai * HALF + m * 16;
#pragma unroll
                for (int bj = 0; bj < 2; ++bj)
#pragma unroll
                    for (int n = 0; n < 2; ++n) *(f32x4*)(out + (size_t)row * 256 + col0 + bj * HALF + n * 16) = acc[ai][bj][m][n]; }
    }
};
template <class E1> struct EpiDual {
    static constexpr bool PERM = false, AFTER_DRAIN = false; static_assert(!E1::PERM && !E1::AFTER_DRAIN, "EpiDual");
    E1 e1; EpiCmp e2;
    __device__ __forceinline__ void operator()(const f32x4 (&acc)[2][2][4][2], const Unit& u, int wr, int wc, int fr, int fq) const { if (u.ty) e2(acc, u, wr, wc, fr, fq); else e1(acc, u, wr, wc, fr, fq); }
};
template <class Epi, class Sched, bool ALIGN_EPI = false, bool SP2 = false>
__device__ __forceinline__ void gemm_phase(PG8_LAS unsigned char* lds, const Gemm g, const Sched& S, const Epi& E) {
    const int tid = threadIdx.x, wid = __builtin_amdgcn_readfirstlane(tid >> 6), lane = tid & 63, wr = wid >> 2, wc = wid & 3, fr = lane & 15, fq = lane >> 4;
    const int K = g.K, nt = K / BK;
    unsigned voffA[2], voffB[2];
#pragma unroll
    for (int i = 0; i < 2; ++i) { int R, C; stage_rc(tid * 16 + i * 8192, R, C); const int Rb = Epi::PERM ? ((R & ~31) + perm32(R & 31)) : R;
        voffA[i] = (unsigned)(R * K + C) * 2u; voffB[i] = (unsigned)(Rb * K + C) * 2u; }
    const size_t kstep = (size_t)(BK * 2);
    const size_t hstep = (size_t)HALF * K * 2;
    const size_t tstep = 2 * hstep;
    const unsigned ldsw = (unsigned)wid * 1024u;
    const int aoff = lds_byte(wr * 64 + fr, fq * 8), boff = lds_byte(wc * 32 + fr, fq * 8);
#define PG8_SA(b, h) (((b) * 2 + (h)) * HTB)
#define PG8_SB(b, h) ((4 + (b) * 2 + (h)) * HTB)
#define PG8_STAGE(bufoff, gbase, voff) do { _Pragma("unroll") for (int _i = 0; _i < 2; ++_i) \
        __builtin_amdgcn_global_load_lds((const unsigned*)((const char*)(gbase) + (voff)[_i]), (PG8_LAS unsigned*)(lds + (bufoff) + ldsw + _i * 8192), 16, 0, 0); } while (0)
#define PG8_LDA(dst, b, h) do { _Pragma("unroll") for (int m = 0; m < 4; ++m) _Pragma("unroll") for (int k = 0; k < 2; ++k) dst[m][k] = *(const PG8_LAS bf16x8*)(lds + PG8_SA(b, h) + aoff + m * 2048 + k * 1024); } while (0)
#define PG8_LDB(dst, b, h) do { _Pragma("unroll") for (int n = 0; n < 2; ++n) _Pragma("unroll") for (int k = 0; k < 2; ++k) dst[n][k] = *(const PG8_LAS bf16x8*)(lds + PG8_SB(b, h) + boff + n * 2048 + k * 1024); } while (0)
#define PG8_MMA(ai, bj, At, Bt) do { __builtin_amdgcn_s_setprio(1); _Pragma("unroll") for (int m = 0; m < 4; ++m) _Pragma("unroll") for (int n = 0; n < 2; ++n) _Pragma("unroll") for (int k = 0; k < 2; ++k) \
        acc[ai][bj][m][n] = __builtin_amdgcn_mfma_f32_16x16x32_bf16(Bt[n][k], At[m][k], acc[ai][bj][m][n], 0, 0, 0); __builtin_amdgcn_s_setprio(0); } while (0)
#define PG8_WAIT_V(n) asm volatile("s_waitcnt vmcnt(" #n ")" ::: "memory")
#define PG8_WAIT_L(n) asm volatile("s_waitcnt lgkmcnt(" #n ")" ::: "memory")
#define PG8_BAR __builtin_amdgcn_s_barrier()
#define PG8_SCHED __builtin_amdgcn_sched_barrier(0)
    Unit cur, nxt; int ui = 0;
    if (!S.next(0, cur)) return;
    f32x4 acc[2][2][4][2];
#pragma unroll
    for (int a = 0; a < 2; ++a)
#pragma unroll
        for (int b = 0; b < 2; ++b)
#pragma unroll
            for (int m = 0; m < 4; ++m)
#pragma unroll
                for (int n = 0; n < 2; ++n) acc[a][b][m][n] = (f32x4){0.f, 0.f, 0.f, 0.f};
    bf16x8 At[4][2], B0[2][2], B1[2][2];
    const char* cA = S.pa(g, cur, tstep); const char* cB = S.pb(g, cur, tstep);
    S.a_ready(cur);
    if constexpr (SP2) {
        PG8_STAGE(PG8_SB(0, 0), cB, voffB); PG8_STAGE(PG8_SB(0, 1), cB + hstep, voffB); PG8_STAGE(PG8_SA(0, 0), cA, voffA); PG8_STAGE(PG8_SA(0, 1), cA + hstep, voffA);
        if (wr == 1) PG8_BAR;
        PG8_WAIT_V(2); PG8_BAR;
        PG8_STAGE(PG8_SB(1, 0), cB + kstep, voffB); PG8_STAGE(PG8_SA(1, 0), cA + kstep, voffA); PG8_STAGE(PG8_SB(1, 1), cB + hstep + kstep, voffB);
        PG8_WAIT_V(6); PG8_BAR;
    } else {
        PG8_STAGE(PG8_SB(0, 0), cB, voffB); PG8_STAGE(PG8_SA(0, 0), cA, voffA); PG8_STAGE(PG8_SB(0, 1), cB + hstep, voffB); PG8_STAGE(PG8_SA(0, 1), cA + hstep, voffA);
        if (wr == 1) PG8_BAR;
        PG8_WAIT_V(4); PG8_BAR;
        PG8_STAGE(PG8_SB(1, 0), cB + kstep, voffB); PG8_STAGE(PG8_SA(1, 0), cA + kstep, voffA); PG8_STAGE(PG8_SB(1, 1), cB + hstep + kstep, voffB);
        PG8_WAIT_V(6); PG8_BAR;
    }
    for (;;) {
        const bool has_next = S.next(ui + 1, nxt);
        const char* nA = has_next ? S.pa(g, nxt, tstep) : cA; const char* nB = has_next ? S.pb(g, nxt, tstep) : cB;
        for (int t = 0; t < nt; t += 2) {
            const bool last = (t == nt - 2);
            const char* a1 = cA + (size_t)(t + 1) * kstep;
            const char* a2 = last ? nA : cA + (size_t)(t + 2) * kstep; const char* b2 = last ? nB : cB + (size_t)(t + 2) * kstep;
            const char* a3 = a2 + kstep; const char* b3 = b2 + kstep;
            if (last && has_next) S.a_ready(nxt);
            if constexpr (SP2) {
            PG8_LDB(B0, 0, 0); PG8_LDB(B1, 0, 1); PG8_SCHED; PG8_LDA(At, 0, 0); PG8_STAGE(PG8_SA(1, 1), a1 + hstep, voffA);
            PG8_WAIT_V(8); PG8_WAIT_L(0); PG8_BAR; PG8_MMA(0, 0, At, B0); PG8_MMA(0, 1, At, B1); PG8_BAR; PG8_SCHED;
            PG8_LDA(At, 0, 1); PG8_STAGE(PG8_SB(0, 0), b2, voffB); PG8_STAGE(PG8_SB(0, 1), b2 + hstep, voffB); PG8_STAGE(PG8_SA(0, 0), a2, voffA);
            PG8_WAIT_V(8); PG8_WAIT_L(0); PG8_BAR; PG8_MMA(1, 0, At, B0); PG8_MMA(1, 1, At, B1); PG8_BAR; PG8_SCHED;
            PG8_LDB(B0, 1, 0); PG8_LDB(B1, 1, 1); PG8_SCHED; PG8_LDA(At, 1, 0); PG8_STAGE(PG8_SA(0, 1), a2 + hstep, voffA);
            PG8_WAIT_V(8); PG8_WAIT_L(0); PG8_BAR; PG8_MMA(0, 0, At, B0); PG8_MMA(0, 1, At, B1); PG8_BAR; PG8_SCHED;
            PG8_LDA(At, 1, 1); PG8_STAGE(PG8_SB(1, 0), b3, voffB); PG8_STAGE(PG8_SB(1, 1), b3 + hstep, voffB); PG8_STAGE(PG8_SA(1, 0), a3, voffA);
            PG8_WAIT_V(8); PG8_WAIT_L(0); PG8_BAR; PG8_MMA(1, 0, At, B0); PG8_MMA(1, 1, At, B1); PG8_BAR; PG8_SCHED;
            } else {
            PG8_LDB(B0, 0, 0); PG8_SCHED; PG8_LDA(At, 0, 0); PG8_STAGE(PG8_SA(1, 1), a1 + hstep, voffA);
            PG8_WAIT_L(8); PG8_BAR; PG8_WAIT_L(0); PG8_MMA(0, 0, At, B0); PG8_BAR; PG8_SCHED;
            PG8_LDB(B1, 0, 1); PG8_STAGE(PG8_SB(0, 0), b2, voffB);
            PG8_BAR; PG8_WAIT_L(0); PG8_MMA(0, 1, At, B1); PG8_BAR;
            PG8_LDA(At, 0, 1); PG8_STAGE(PG8_SA(0, 0), a2, voffA);
            PG8_BAR; PG8_WAIT_L(0); PG8_MMA(1, 0, At, B0); PG8_BAR; PG8_SCHED;
            PG8_STAGE(PG8_SB(0, 1), b2 + hstep, voffB);
            PG8_WAIT_V(6); PG8_BAR; PG8_MMA(1, 1, At, B1); PG8_BAR;
            PG8_LDB(B0, 1, 0); PG8_SCHED; PG8_LDA(At, 1, 0); PG8_STAGE(PG8_SA(0, 1), a2 + hstep, voffA);
            PG8_WAIT_L(8); PG8_BAR; PG8_WAIT_L(0); PG8_MMA(0, 0, At, B0); PG8_BAR; PG8_SCHED;
            PG8_LDB(B1, 1, 1); PG8_STAGE(PG8_SB(1, 0), b3, voffB);
            PG8_BAR; PG8_WAIT_L(0); PG8_MMA(0, 1, At, B1); PG8_BAR;
            PG8_LDA(At, 1, 1); PG8_STAGE(PG8_SA(1, 0), a3, voffA);
            PG8_BAR; PG8_WAIT_L(0); PG8_MMA(1, 0, At, B0); PG8_BAR; PG8_SCHED;
            PG8_STAGE(PG8_SB(1, 1), b3 + hstep, voffB);
            PG8_WAIT_V(6); PG8_BAR; PG8_MMA(1, 1, At, B1); PG8_BAR;
            }
        }
        if constexpr (ALIGN_EPI) { if (wr == 0) PG8_BAR; }
        if constexpr (!Epi::AFTER_DRAIN) { E(acc, cur, wr, wc, fr, fq); S.done(cur); }
        if (!has_next) break;
#pragma unroll
        for (int a = 0; a < 2; ++a)
#pragma unroll
            for (int b = 0; b < 2; ++b)
#pragma unroll
                for (int m = 0; m < 4; ++m)
#pragma unroll
                    for (int n = 0; n < 2; ++n) acc[a][b][m][n] = (f32x4){0.f, 0.f, 0.f, 0.f};
        cur = nxt; cA = nA; cB = nB; ++ui;
        if constexpr (ALIGN_EPI) { if (wr == 1) PG8_BAR; }
    }
    PG8_WAIT_V(0);
    if constexpr (!ALIGN_EPI) { if (wr == 0) PG8_BAR; }
    PG8_BAR;
    if constexpr (Epi::AFTER_DRAIN) { E.fused(acc, cur, wr, wc, fr, fq, lds, wid, lane); S.done(cur); }
#undef PG8_SA
#undef PG8_SB
#undef PG8_STAGE
#undef PG8_LDA
#undef PG8_LDB
#undef PG8_MMA
#undef PG8_WAIT_V
#undef PG8_WAIT_L
#undef PG8_BAR
#undef PG8_SCHED
}
}
#define RLX_AGENT __ATOMIC_RELAXED, __HIP_MEMORY_SCOPE_AGENT
#define XB_TMO      128
#define XB_XCNT(j)  (256  + 64 * (j))
#define XB_XSUB(j)  (1280 + 64 * (j))
#define XB_XGEN(j)  (2304 + 64 * (j))
#define XB_TOP      3328
#define XB_TOPGEN   3392
#define XCD_BAR_WORDS 3456
#define XB_SPIN_CAP (1u << 18)

__device__ __forceinline__ unsigned xb_ld(unsigned* p)              { return __hip_atomic_load(p, __ATOMIC_RELAXED, __HIP_MEMORY_SCOPE_AGENT); }
__device__ __forceinline__ unsigned xb_add(unsigned* p, unsigned v) { return __hip_atomic_fetch_add(p, v, __ATOMIC_RELAXED, __HIP_MEMORY_SCOPE_AGENT); }
__device__ __forceinline__ unsigned xb_xcc_id() { return (unsigned)__builtin_amdgcn_s_getreg((3 << 11) | 20) & 0xFu; }
#define XB_SPIN(cond, bar) do { unsigned _sp = 0; while (cond) { __builtin_amdgcn_s_sleep(1); \
    if ((++_sp & 255u) == 0u) { if (xb_ld(&(bar)[XB_TMO])) break; if (_sp > XB_SPIN_CAP) { atomicAdd(&(bar)[XB_TMO], 1u); break; } } } } while (0)

struct XcdBarrier {
    unsigned* bar; unsigned x;
    volatile LAS unsigned* st;
};

__device__ __forceinline__ XcdBarrier xcd_barrier_post(unsigned* bar, volatile LAS unsigned* st) {
    XcdBarrier b; b.bar = bar; b.x = xb_xcc_id(); b.st = st;
    if (threadIdx.x == 0) (void)xb_add(&bar[XB_XCNT(b.x)], 1u);
    return b;
}
__device__ __forceinline__ void xcd_barrier_complete(unsigned* bar, unsigned x, unsigned& nloc, unsigned& nx) {
    const unsigned G = gridDim.x * gridDim.y * gridDim.z;
    unsigned sum, cnt, mine, sp = 0u;
    for (;;) {
        sum = 0u; cnt = 0u; mine = 0u;
#pragma unroll
        for (unsigned j = 0; j < 16; ++j) { const unsigned c = xb_ld(&bar[XB_XCNT(j)]); sum += c; cnt += (c > 0u) ? 1u : 0u; mine = (j == x) ? c : mine; }
        if (sum == G) break;
        __builtin_amdgcn_s_sleep(1);
        if ((++sp & 255u) == 0u) { if (xb_ld(&bar[XB_TMO])) break; if (sp > XB_SPIN_CAP) { atomicAdd(&bar[XB_TMO], 1u); break; } }
    }
    nloc = mine > 0u ? mine : 1u; nx = cnt > 0u ? cnt : 1u;
}

__device__ __forceinline__ void xcd_barrier(const XcdBarrier& b) {
    asm volatile("s_waitcnt vmcnt(0)" ::: "memory");
    __syncthreads();
    if (threadIdx.x == 0) {
        unsigned* bar = b.bar;
        __builtin_amdgcn_s_waitcnt(0);
        unsigned nloc = b.st[0], nx = b.st[1];
        if (nloc == 0u) { xcd_barrier_complete(bar, b.x, nloc, nx); b.st[0] = nloc; b.st[1] = nx; }
        const unsigned old = xb_add(&bar[XB_XSUB(b.x)], 1u);
        const unsigned gen = old / nloc;
        if (old + 1u == (gen + 1u) * nloc) {
            __builtin_amdgcn_fence(__ATOMIC_RELEASE, "agent");
            asm volatile("s_waitcnt vmcnt(0)" ::: "memory");
            const unsigned og = xb_add(&bar[XB_TOP], 1u);
            const unsigned tg = og / nx;
            if (og + 1u == (tg + 1u) * nx) xb_add(&bar[XB_TOPGEN], 1u);
            else XB_SPIN(xb_ld(&bar[XB_TOPGEN]) == tg, bar);
            __builtin_amdgcn_fence(__ATOMIC_ACQUIRE, "agent");
            xb_add(&bar[XB_XGEN(b.x)], 1u);
            asm volatile("s_waitcnt vmcnt(0)" ::: "memory");
        } else {
            XB_SPIN(xb_ld(&bar[XB_XGEN(b.x)]) == gen, bar);
            __builtin_amdgcn_fence(__ATOMIC_ACQUIRE, "agent");
            asm volatile("s_waitcnt vmcnt(0)" ::: "memory");
        }
    }
    __syncthreads();
}
struct Params {
    const float *x_prompt, *x_sample, *cache; const int* pt;
    const float *win_state, *conv_state, *hg_state, *tb, *g_mix, *g_mlp, *w_up, *w_dn, *w_in, *w_out, *q_g, *k_g, *cmp_pe, *cmp_w1, *cmp_b1, *cmp_w2,
                *conv_w, *conv_b, *ln_g, *ln_b, *hg_w_in, *hg_w_out, *hg_lb, *hg_ng;
    float* out; unsigned* ctl;
    bf16_t *Wt_in, *Wt_out0, *Wt_up0, *Wt_dn0, *Wt_hgin, *Wt_hgout, *Wt_up1, *Wt_dn1, *W1cmp;
    float *cbv, *lbv;
    bf16_t* xb; float *ssp0, *ssp1, *ssp2, *ssp3, *ssps1, *ssps2, *ssps3;
    bf16_t *Qs, *Kc, *VcT, *Ksel, *VselT, *Kwin, *VwinT, *KwinS, *VwinST, *KselSn, *VselSTn;
    float *proj, *glu, *qn, *kvw, *gates; bf16_t *ao, *aochk, *acmp; float *hfs, *kcvc, *x1, *x2, *x3; bf16_t* hid; float *hgp, *dS, *Dtot, *Sst, *og;
    int ph_lo, ph_hi;
};
constexpr int NWAVES = 8, NTHR = 512;
constexpr int LDS_BYTES = 163840, RING_BYTES = 131072, MISC_OFF = LDS_BYTES - 256;
constexpr int CW_BAR = 4096;
constexpr size_t CTL_BYTES = 1u << 20;

__device__ __forceinline__ void transpose_item(const float* __restrict__ W, const float* __restrict__ g, int K, int N, bf16_t* __restrict__ WT, float* scr, int item, int nblk, int lane) {
    const int kb = item / nblk, nb = item % nblk, k0 = 64 * kb, n0 = 32 * nb;
#pragma unroll 8
    for (int i = 0; i < 32; ++i) { const int kk = 2 * i + (lane >> 5), n = n0 + (lane & 31); float v = 0.f; if (n < N) { v = W[(size_t)(k0 + kk) * N + n]; if (g) v *= g[k0 + kk]; } scr[kk * 33 + (lane & 31)] = v; }
    LDS_WAIT(); asm volatile("" ::: "memory");
    const int c = lane & 7;
#pragma unroll
    for (int j = 0; j < 4; ++j) { const int n = (lane >> 3) + 8 * j; const float* s = scr + (8 * c) * 33 + n;
        v4u o; o.x = pk2(s[0 * 33], s[1 * 33]); o.y = pk2(s[2 * 33], s[3 * 33]); o.z = pk2(s[4 * 33], s[5 * 33]); o.w = pk2(s[6 * 33], s[7 * 33]);
        *(v4u*)(WT + (size_t)(n0 + n) * K + k0 + 8 * c) = o; }
    LDS_WAIT(); asm volatile("" ::: "memory");
}
__device__ __forceinline__ void p0_prologue(const Params& P, unsigned char* lds, int G, int repA, int repB, int repC) {
    const int tid = otid(), lane = tid & 63, wave = __builtin_amdgcn_readfirstlane(tid >> 6), gw = blockIdx.x * NWAVES + wave, NGW = G * NWAVES;
    float* scr = (float*)(lds + wave * 16384);
    constexpr int I_IN = (D / 64) * (NINP / 32), I_SQ = (D / 64) * (D / 32), I_UP = (D / 64) * (FF / 32), I_DN = (FF / 64) * (D / 32);
    constexpr int NITEMS = I_IN + 2 * I_SQ + 3 * I_UP + 2 * I_DN;
    for (int ra = 0; ra < repA; ++ra)
    for (int it = gw; it < NITEMS; it += NGW) {
        int r = it;
        if (r < I_IN) { transpose_item(P.w_in, P.g_mix, D, NIN, P.Wt_in, scr, r, NINP / 32, lane); continue; } r -= I_IN;
        if (r < I_SQ) { transpose_item(P.w_out, nullptr, D, D, P.Wt_out0, scr, r, D / 32, lane); continue; } r -= I_SQ;
        if (r < I_SQ) { transpose_item(P.hg_w_out, nullptr, D, D, P.Wt_hgout, scr, r, D / 32, lane); continue; } r -= I_SQ;
        if (r < I_UP) { transpose_item(P.w_up, P.g_mlp, D, FF, P.Wt_up0, scr, r, FF / 32, lane); continue; } r -= I_UP;
        if (r < I_UP) { transpose_item(P.w_up + (size_t)D * FF, P.g_mlp + D, D, FF, P.Wt_up1, scr, r, FF / 32, lane); continue; } r -= I_UP;
        if (r < I_UP) { transpose_item(P.hg_w_in, P.g_mix + D, D, FF, P.Wt_hgin, scr, r, FF / 32, lane); continue; } r -= I_UP;
        if (r < I_DN) { transpose_item(P.w_dn, nullptr, FF, D, P.Wt_dn0, scr, r, D / 32, lane); continue; } r -= I_DN;
        transpose_item(P.w_dn + (size_t)D * FF, nullptr, FF, D, P.Wt_dn1, scr, r, D / 32, lane);
    }
    const int gt = blockIdx.x * NTHR + tid, NGT = G * NTHR;
    for (int idx = gt; idx < 2 * 256 * 1024; idx += NGT) {
        const int k = idx & 1023, n = (idx >> 10) & 255, kv = idx >> 18, s = k >> 6, d = k & 63, h = n >> 7, f = n & 127;
        P.W1cmp[idx] = (bf16_t)f2bf(P.cmp_w1[(((size_t)kv * 32 + 16 * h + s) * 64 + d) * 128 + f]);
    }
    for (int it = gw; it < 256; it += NGW) { const int kv = it >> 7, f = it & 127; float a = 0.f;
        for (int sd = lane; sd < 2048; sd += 64) a += P.cmp_pe[kv * 2048 + sd] * P.cmp_w1[((size_t)kv * 2048 + sd) * 128 + f];
        a = wave_sum(a); if (lane == 0) P.cbv[it] = a + P.cmp_b1[it]; }
    for (int c = gt; c < D; c += NGT) { const float l0 = P.hg_lb[c], l1 = P.hg_lb[D + c], m = fmaxf(l0, l1), e0 = __expf(l0 - m), e1 = __expf(l1 - m), s = e0 + e1; const float p0 = e0 / s, p1 = e1 / s; P.lbv[c] = (p0 + p1) - p0; }
    for (int rc = 0; rc < repC; ++rc)
    for (int row = gw; row < MR; row += NGW) {
        const float* xr = row < TP ? P.x_prompt + (size_t)row * D : P.x_sample + (size_t)(row - TP) * D; bf16_t* o = P.xb + (size_t)row * D;
        float s = 0.f;
#pragma unroll
        for (int j = 0; j < 4; ++j) { const f32x4 v = *(const f32x4*)(xr + 4 * lane + 256 * j); s += (v.x * v.x + v.y * v.y) + (v.z * v.z + v.w * v.w); v2u w; w.x = pk2(v.x, v.y); w.y = pk2(v.z, v.w); *(v2u*)(o + 4 * lane + 256 * j) = w; }
        s = wave_sum(s);
        if (lane < 16) P.ssp0[(size_t)row * 16 + lane] = lane == 0 ? s : 0.f;
    }
    for (int rb = 0; rb < repB; ++rb)
    for (int it0 = gw; it0 < 2 * 32 * 1024; it0 += 2 * NGW) {
        const int tp = lane >> 5, pc = lane & 31, hkvl = pc >> 4, dq = (pc & 15) * 4;
        f32x4 v[2][8]; bf16_t* dst[2];
#pragma unroll
        for (int u = 0; u < 2; ++u) { const int it = it0 + u * NGW, c = it & 1023, b = (it >> 10) & 31, kv = it >> 15;
            const int page = P.pt[b * NPAGES + (c >> 3)];
            const float* src = P.cache + (((size_t)page * 128 + (c & 7) * 16 + tp) * 4 + kv) * 128 + pc * 4;
            dst[u] = P.acmp + ((size_t)kv * CMPROWS + ((size_t)(b + 1) * 2 + hkvl) * 1024 + c) * 1024 + tp * 64 + dq;
#pragma unroll
            for (int s = 0; s < 8; ++s) v[u][s] = *(const f32x4*)(src + (size_t)s * 1024); }
#pragma unroll
        for (int u = 0; u < 2; ++u)
#pragma unroll
            for (int s = 0; s < 8; ++s) { v2u w; w.x = pk2(v[u][s].x, v[u][s].y); w.y = pk2(v[u][s].z, v[u][s].w); *(v2u*)(dst[u] + s * 128) = w; }
    }
    for (int idx = gt; idx < 32 * 512 * 256; idx += NGT) { const int dd = idx & 63, hkv = (idx >> 6) & 1, kv = (idx >> 7) & 1, i = (idx >> 8) & 511, b = idx >> 17; const bf16_t x = (bf16_t)f2bf(P.win_state[idx]);
        if (kv == 0) P.KwinS[((size_t)(b * 2 + hkv) * 544 + i) * 64 + dd] = x; else P.VwinST[((size_t)(b * 2 + hkv) * 64 + dd) * 544 + i] = x; }
    for (int idx = gt; idx < 32 * 508 * 256; idx += NGT) { const int b = idx / (508 * 256), r = idx % (508 * 256); P.out[OFF_WINS + (size_t)b * 512 * 256 + r] = P.win_state[(size_t)b * 512 * 256 + 4 * 256 + r]; }
    for (int idx = gt; idx < 32 * 26 * 512; idx += NGT) { const int b = idx / (26 * 512), r = idx % (26 * 512); P.out[OFF_CONVS + (size_t)b * 30 * 512 + r] = P.conv_state[(size_t)b * 30 * 512 + 4 * 512 + r]; }
}

struct SEpProj { float* proj; const float* ssp; static constexpr bool STATS = false; __device__ __forceinline__ void stat(int, int, float) const {}
    __device__ __forceinline__ f32x4 operator()(int m, int n, f32x4 a) const { if (n < NIN) *(f32x4*)(proj + (size_t)m * NIN + n) = a * row_r(ssp, m); return a; } };
struct SEpResid { const float* xin; float* out; bf16_t* xb; float* ssps; int xoff; int pad; static constexpr bool STATS = true;
    __device__ __forceinline__ f32x4 operator()(int m, int n, f32x4 a) const { const f32x4 o = *(const f32x4*)(xin + (size_t)(m - xoff) * D + n) + a; *(f32x4*)(out + (size_t)m * D + n) = o;
        if (xb) { v2u w; w.x = pk2(o[0], o[1]); w.y = pk2(o[2], o[3]); *(v2u*)(xb + (size_t)m * D + n) = w; } return o; }
    __device__ __forceinline__ void stat(int row, int slab, float q) const { if (ssps) ssps[(size_t)row * 64 + slab] = q; } };
struct SEpUp { bf16_t* hid; const float* rtab; static constexpr bool STATS = false; __device__ __forceinline__ void stat(int, int, float) const {}
    __device__ __forceinline__ f32x4 operator()(int m, int n, f32x4 a) const { const float r = rtab[m - TP]; f32x4 v;
#pragma unroll
        for (int i = 0; i < 4; ++i) { const float t = fmaxf(a[i] * r, 0.f); v[i] = t * t; }
        v2u w; w.x = pk2(v[0], v[1]); w.y = pk2(v[2], v[3]); *(v2u*)(hid + (size_t)m * FF + n) = w; return a; } };
struct SEpScale { float* out; const float* rtab; int ld; int pad; static constexpr bool STATS = false; __device__ __forceinline__ void stat(int, int, float) const {}
    __device__ __forceinline__ f32x4 operator()(int m, int n, f32x4 a) const { *(f32x4*)(out + (size_t)m * ld + n) = a * rtab[m - TP]; return a; } };
__device__ __forceinline__ void sample_rtab(const float* __restrict__ ssps, float* rtab) {
    const int tid = otid();
    if (tid < SR) { float s = 0.f; const f32x4* p = (const f32x4*)(ssps + (size_t)tid * 64);
#pragma unroll
        for (int j = 0; j < 16; ++j) { const f32x4 v = p[j]; s += (v.x + v.y) + (v.z + v.w); }
        rtab[tid] = rsqrtf(s * (1.f / D) + EPS); }
    __syncthreads();
}
template <class EP>
__device__ __forceinline__ void sgemm_mfma(const bf16_t* __restrict__ A, const bf16_t* __restrict__ Bt, int N, int K, const EP& ep, unsigned char* lds, int G) {
    typedef short bf16x8_ __attribute__((ext_vector_type(8)));
    const int tid = otid(), wave = __builtin_amdgcn_readfirstlane(tid >> 6), lane = tid & 63, c = lane & 15, rq = lane >> 4;
    float* part = (float*)lds;
    const int kper = K / NWAVES, kbeg = wave * kper;
    for (int it = blockIdx.x; it < N / 16; it += G) {
        const int n0 = it * 16;
        f32x4 acc[8];
#pragma unroll
        for (int rt = 0; rt < 8; ++rt) acc[rt] = (f32x4){0.f, 0.f, 0.f, 0.f};
        const bf16_t* bp = Bt + (size_t)(n0 + c) * K + kbeg + rq * 8; const bf16_t* ap = A + (size_t)(TP + c) * K + kbeg + rq * 8;
        for (int k = 0; k < kper; k += 64) {
            bf16x8_ b0 = *(const bf16x8_*)(bp + k), b1 = *(const bf16x8_*)(bp + k + 32); bf16x8_ a0[8], a1[8];
#pragma unroll
            for (int rt = 0; rt < 8; ++rt) { a0[rt] = *(const bf16x8_*)(ap + (size_t)rt * 16 * K + k); a1[rt] = *(const bf16x8_*)(ap + (size_t)rt * 16 * K + k + 32); }
#pragma unroll
            for (int rt = 0; rt < 8; ++rt) { acc[rt] = __builtin_amdgcn_mfma_f32_16x16x32_bf16(a0[rt], b0, acc[rt], 0, 0, 0); acc[rt] = __builtin_amdgcn_mfma_f32_16x16x32_bf16(a1[rt], b1, acc[rt], 0, 0, 0); }
        }
#pragma unroll
        for (int rt = 0; rt < 8; ++rt)
#pragma unroll
            for (int i = 0; i < 4; ++i) part[(wave * 128 + rt * 16 + 4 * rq + i) * 16 + c] = acc[rt][i];
        __syncthreads();
        { const int row = tid >> 2, cg = (tid & 3) * 4; f32x4 s = *(const f32x4*)(part + row * 16 + cg);
#pragma unroll
            for (int w = 1; w < 8; ++w) s = s + *(const f32x4*)(part + (w * 128 + row) * 16 + cg);
            const f32x4 o = ep(TP + row, n0 + cg, s);
            if (EP::STATS) { float q = (o[0] * o[0] + o[1] * o[1]) + (o[2] * o[2] + o[3] * o[3]); q += __shfl_xor(q, 1); q += __shfl_xor(q, 2); if ((tid & 3) == 0) ep.stat(row, it, q); } }
        __syncthreads();
    }
}

__device__ __forceinline__ float grp8_sum(float x) { x += __shfl_xor(x, 1); x += __shfl_xor(x, 2); x += __shfl_xor(x, 4); return x; }
__device__ __forceinline__ void p2_elem(const Params& P, unsigned char* lds, int G) {
    const int tid = otid(), wave = __builtin_amdgcn_readfirstlane(tid >> 6), lane = tid & 63;
    float* out = P.out;
    bf16_t* vt = (bf16_t*)lds;
    const int l8 = lane * 8;
    for (int tile = blockIdx.x; tile < MR / 64; tile += G) {
        for (int r = wave; r < 64; r += NWAVES) {
            const int m = tile * 64 + r;
            const float* p = P.proj + (size_t)m * NIN;
            { const f32x4 a0 = *(const f32x4*)(p + l8), a1 = *(const f32x4*)(p + l8 + 4), g0 = *(const f32x4*)(p + CC + l8), g1 = *(const f32x4*)(p + CC + l8 + 4); f32x4 o0, o1;
#pragma unroll
              for (int i = 0; i < 4; ++i) { o0[i] = a0[i] * sigmoidf_(g0[i]); o1[i] = a1[i] * sigmoidf_(g1[i]); }
              *(f32x4*)(P.glu + (size_t)m * CC + l8) = o0; *(f32x4*)(P.glu + (size_t)m * CC + l8 + 4) = o1; }
            { f32x4 v0 = *(const f32x4*)(p + 1024 + l8), v1 = *(const f32x4*)(p + 1024 + l8 + 4);
              float s = ((v0[0] * v0[0] + v0[1] * v0[1]) + (v0[2] * v0[2] + v0[3] * v0[3])) + ((v1[0] * v1[0] + v1[1] * v1[1]) + (v1[2] * v1[2] + v1[3] * v1[3]));
              s = grp8_sum(s); const float rs = rsqrtf(s * (1.f / 64.f) + EPS); const int dq = (lane & 7) * 8;
              const f32x4 g0 = *(const f32x4*)(P.q_g + dq), g1 = *(const f32x4*)(P.q_g + dq + 4);
              v0 = v0 * rs * g0; v1 = v1 * rs * g1;
              { const float cs = 0.125f * 1.4426950408889634f; v4u w; w.x = pk2(v0[0] * cs, v0[1] * cs); w.y = pk2(v0[2] * cs, v0[3] * cs); w.z = pk2(v1[0] * cs, v1[1] * cs); w.w = pk2(v1[2] * cs, v1[3] * cs); *(v4u*)(P.Qs + (size_t)m * 512 + l8) = w; } }
#pragma unroll
            for (int pass = 0; pass < 2; ++pass) {
                if (pass == 1 && lane >= 32) break;
                const int col = pass * 512 + l8, gi = col >> 6, dq = col & 63, s = gi >> 2, kv01 = (gi >> 1) & 1, hkv = gi & 1;
                f32x4 v0 = *(const f32x4*)(p + 1536 + col), v1 = *(const f32x4*)(p + 1536 + col + 4);
                float ss = ((v0[0] * v0[0] + v0[1] * v0[1]) + (v0[2] * v0[2] + v0[3] * v0[3])) + ((v1[0] * v1[0] + v1[1] * v1[1]) + (v1[2] * v1[2] + v1[3] * v1[3]));
                ss = grp8_sum(ss);
                if (kv01 == 0 && s >= 1) { const float rs = rsqrtf(ss * (1.f / 64.f) + EPS); const f32x4 g0 = *(const f32x4*)(P.k_g + s * 64 + dq), g1 = *(const f32x4*)(P.k_g + s * 64 + dq + 4); v0 = v0 * rs * g0; v1 = v1 * rs * g1; }
                v4u wb; wb.x = pk2(v0[0], v0[1]); wb.y = pk2(v0[2], v0[3]); wb.z = pk2(v1[0], v1[1]); wb.w = pk2(v1[2], v1[3]);
                if (m >= TP && s >= 1) { const int b = (m - TP) >> 2, tt = (m - TP) & 3, bh = b * 2 + hkv; const unsigned ww[4] = {wb.x, wb.y, wb.z, wb.w};
                    if (kv01 == 0) *(v4u*)((s == 1 ? P.KselSn + ((size_t)bh * 64 + tt) * 64 : P.KwinS + ((size_t)bh * 544 + 512 + tt) * 64) + dq) = wb;
                    else {
#pragma unroll
                        for (int e = 0; e < 8; ++e) { const bf16_t x = (bf16_t)((ww[e >> 1] >> ((e & 1) * 16)) & 0xffff);
                            if (s == 1) P.VselSTn[((size_t)bh * 64 + dq + e) * 64 + tt] = x; else P.VwinST[((size_t)bh * 64 + dq + e) * 544 + 512 + tt] = x; } } }
                if (s < 2) { const int slot = s * 2 + kv01;
                    float* o = m < TP ? out + OFF_KVP + ((size_t)m * 4 + slot) * 128 + hkv * 64 + dq : out + OFF_KVS + ((size_t)(m - TP) * 4 + slot) * 128 + hkv * 64 + dq;
                    *(f32x4*)o = v0; *(f32x4*)(o + 4) = v1;
                    if (s == 0 && m < TP) *(v4u*)(P.acmp + ((size_t)kv01 * CMPROWS + (size_t)hkv * 1024 + (m >> 4)) * 1024 + (m & 15) * 64 + dq) = wb;
                } else {
                    float* o = nullptr;
                    if (m < TP) { if (m >= TP - 512) o = out + OFF_WINP + ((size_t)(m - (TP - 512)) * 2 + kv01) * 128 + hkv * 64 + dq; }
                    else { const int b = (m - TP) >> 2, tt = (m - TP) & 3; o = out + OFF_WINS + (((size_t)b * 512 + 508 + tt) * 2 + kv01) * 128 + hkv * 64 + dq; }
                    if (o) { *(f32x4*)o = v0; *(f32x4*)(o + 4) = v1; }
                }
                if (s >= 1 && m < TP) {
                    if (kv01 == 0) *(v4u*)((s == 1 ? P.Ksel : P.Kwin) + ((size_t)hkv * TP + m) * 64 + dq) = wb;
                    else { bf16_t* vb = vt + (((s - 1) * 2 + hkv) * 64 + dq) * 72 + r;
                        vb[0] = (bf16_t)(wb.x & 0xffff); vb[72] = (bf16_t)(wb.x >> 16); vb[144] = (bf16_t)(wb.y & 0xffff); vb[216] = (bf16_t)(wb.y >> 16);
                        vb[288] = (bf16_t)(wb.z & 0xffff); vb[360] = (bf16_t)(wb.z >> 16); vb[432] = (bf16_t)(wb.w & 0xffff); vb[504] = (bf16_t)(wb.w >> 16); }
                }
            }
            if (lane < 24) P.gates[(size_t)m * 24 + lane] = sigmoidf_(p[2304 + lane]);
        }
        __syncthreads();
        if (tile < TP / 64) {
#pragma unroll
            for (int i = 0; i < 4; ++i) { const int pc = tid + 512 * i, mat = pc >> 9, d = (pc >> 3) & 63, rs = pc & 7;
                const v4u w = *(const v4u*)(vt + (mat * 64 + d) * 72 + rs * 8);
                *(v4u*)((mat < 2 ? P.VselT : P.VwinT) + (((size_t)(mat & 1) * 256 + tile) * 64 + d) * 64 + rs * 8) = w; }
        }
        __syncthreads();
    }
}
__device__ __forceinline__ void p3_conv(const Params& P, unsigned char* lds, int G) {
    float* wl = (float*)lds;
    const int tid = otid(), wave = __builtin_amdgcn_readfirstlane(tid >> 6), lane = tid & 63, c0 = lane * 8;
    for (int i = tid; i < CWID * CC; i += NTHR) wl[i] = P.conv_w[i];
    __syncthreads();
    f32x4 cb0 = *(const f32x4*)(P.conv_b + c0), cb1 = *(const f32x4*)(P.conv_b + c0 + 4), lg0 = *(const f32x4*)(P.ln_g + c0), lg1 = *(const f32x4*)(P.ln_g + c0 + 4), lb0 = *(const f32x4*)(P.ln_b + c0), lb1 = *(const f32x4*)(P.ln_b + c0 + 4);
    for (int rg = blockIdx.x * NWAVES + wave; rg < MR / 8; rg += G * NWAVES) {
#pragma unroll 1
        for (int k = 0; k < 8; ++k) {
            const int m = rg * 8 + k;
            f32x4 a0 = cb0, a1 = cb1;
            if (m < TP) {
                const int w0 = m < 30 ? 30 - m : 0;
#pragma unroll 4
                for (int w = w0; w < CWID; ++w) { const float* x = P.glu + (size_t)(m - 30 + w) * CC + c0; const f32x4 x0 = *(const f32x4*)x, x1 = *(const f32x4*)(x + 4);
                    a0 = a0 + x0 * *(const f32x4*)(wl + w * CC + c0); a1 = a1 + x1 * *(const f32x4*)(wl + w * CC + c0 + 4); }
            } else { const int b = (m - TP) >> 2, tt = (m - TP) & 3;
#pragma unroll 4
                for (int w = 0; w < CWID; ++w) { const int i = tt + w; const float* x = (i < 30 ? P.conv_state + ((size_t)b * 30 + i) * CC : P.glu + (size_t)(TP + 4 * b + (i - 30)) * CC) + c0;
                    const f32x4 x0 = *(const f32x4*)x, x1 = *(const f32x4*)(x + 4);
                    a0 = a0 + x0 * *(const f32x4*)(wl + w * CC + c0); a1 = a1 + x1 * *(const f32x4*)(wl + w * CC + c0 + 4); }
            }
            const float mean = wave_sum(((a0.x + a0.y) + (a0.z + a0.w)) + ((a1.x + a1.y) + (a1.z + a1.w))) * (1.f / CC);
            a0 = a0 - mean; a1 = a1 - mean;
            const float var = wave_sum(((a0.x * a0.x + a0.y * a0.y) + (a0.z * a0.z + a0.w * a0.w)) + ((a1.x * a1.x + a1.y * a1.y) + (a1.z * a1.z + a1.w * a1.w))) * (1.f / CC);
            const float rs = rsqrtf(var + EPS);
            f32x4 z0 = a0 * rs * lg0 + lb0, z1 = a1 * rs * lg1 + lb1;
#pragma unroll
            for (int i = 0; i < 4; ++i) { z0[i] = z0[i] * sigmoidf_(z0[i]); z1[i] = z1[i] * sigmoidf_(z1[i]); }
            v4u o; o.x = pk2(z0.x, z0.y); o.y = pk2(z0.z, z0.w); o.z = pk2(z1.x, z1.y); o.w = pk2(z1.z, z1.w);
            *(v4u*)(P.ao + (size_t)m * D + c0) = o;
        }
    }
    const int gt = blockIdx.x * NTHR + tid, NGT = G * NTHR;
    for (int j = gt; j < 30 * 512; j += NGT) P.out[OFF_CONVP + j] = P.glu[(size_t)(TP - 30) * CC + j];
    for (int j = gt; j < 32 * 4 * 512; j += NGT) { const int b = j / 2048, r = j % 2048; P.out[OFF_CONVS + (size_t)b * 30 * 512 + 26 * 512 + r] = P.glu[(size_t)(TP + 4 * b) * CC + r]; }
    __syncthreads();
}
__device__ __forceinline__ void p4_cmp_finish(const Params& P, unsigned char* lds, int G) {
    typedef short bf16x8_ __attribute__((ext_vector_type(8)));
    const int tid = otid(), wave = __builtin_amdgcn_readfirstlane(tid >> 6), lane = tid & 63, c = lane & 15, rq = lane >> 4;
    bf16_t* W2T = (bf16_t*)lds;
    for (int i = tid; i < 2 * 128 * 64; i += NTHR) { const int kv = i >> 13, f = (i >> 6) & 127, d = i & 63; W2T[(kv * 64 + d) * 136 + f] = (bf16_t)f2bf(P.cmp_w2[i]); }
    __syncthreads();
    constexpr int NGRP = 64, NIT = 2 * 66 * NGRP;
    for (int it = blockIdx.x * NWAVES + wave; it < NIT; it += G * NWAVES) {
        const int grp = it & 63, sh = (it >> 6) % 66, kv01 = it / (64 * 66);
        const float* hfs = P.hfs + (size_t)kv01 * CMPROWS * 256;
        const int j = grp * 16 + c;
        const bool jok = j < NCMP;
        bf16x8_ af[4];
#pragma unroll
        for (int ks = 0; ks < 4; ++ks) { const int f0 = ks * 32 + rq * 8; float x[8];
            if (jok) { const float* h1 = hfs + ((size_t)sh * 1024 + j) * 256 + f0; const float* h2 = hfs + ((size_t)sh * 1024 + j + 1) * 256 + 128 + f0; const float* cb = P.cbv + kv01 * 128 + f0;
                const f32x4 a0 = *(const f32x4*)h1, a1 = *(const f32x4*)(h1 + 4), b0 = *(const f32x4*)h2, b1 = *(const f32x4*)(h2 + 4), c0 = *(const f32x4*)cb, c1 = *(const f32x4*)(cb + 4);
#pragma unroll
                for (int i = 0; i < 4; ++i) { x[i] = a0[i] + b0[i] + c0[i]; x[4 + i] = a1[i] + b1[i] + c1[i]; } }
            else {
#pragma unroll
                for (int i = 0; i < 8; ++i) x[i] = 0.f; }
#pragma unroll
            for (int i = 0; i < 8; ++i) { const float u = 0.7978845608028654f * (x[i] + 0.044715f * x[i] * x[i] * x[i]); const float th = 1.f - 2.f / (1.f + __expf(2.f * u)); x[i] = 0.5f * x[i] * (1.f + th); }
            v4u w; w.x = pk2(x[0], x[1]); w.y = pk2(x[2], x[3]); w.z = pk2(x[4], x[5]); w.w = pk2(x[6], x[7]); af[ks] = __builtin_bit_cast(bf16x8_, w); }
        f32x4 o[4];
#pragma unroll
        for (int dt = 0; dt < 4; ++dt) { o[dt] = (f32x4){0.f, 0.f, 0.f, 0.f};
#pragma unroll
            for (int ks = 0; ks < 4; ++ks) o[dt] = __builtin_amdgcn_mfma_f32_16x16x32_bf16(af[ks], *(const bf16x8_*)(W2T + (kv01 * 64 + dt * 16 + c) * 136 + ks * 32 + rq * 8), o[dt], 0, 0, 0); }
        const int seq = sh >> 1, hkv = sh & 1;
#pragma unroll
        for (int i = 0; i < 4; ++i) {
            const int jj = grp * 16 + 4 * rq + i;
            float v[4] = {o[0][i], o[1][i], o[2][i], o[3][i]};
            if (kv01 == 0) { float s = (v[0] * v[0] + v[1] * v[1]) + (v[2] * v[2] + v[3] * v[3]); s += __shfl_xor(s, 1); s += __shfl_xor(s, 2); s += __shfl_xor(s, 4); s += __shfl_xor(s, 8);
                const float rs = rsqrtf(s * (1.f / 64.f) + EPS);
#pragma unroll
                for (int dt = 0; dt < 4; ++dt) v[dt] = v[dt] * rs * P.k_g[dt * 16 + c]; }
            if (jj < NCMP) {
#pragma unroll
                for (int dt = 0; dt < 4; ++dt) { const int d = dt * 16 + c;
                    if (kv01 == 0) P.Kc[(((size_t)seq * 2 + hkv) * 1024 + jj) * 64 + d] = (bf16_t)f2bf(v[dt]); else P.VcT[((((size_t)seq * 2 + hkv) * 32 + (jj >> 5)) * 64 + d) * 32 + (jj & 31)] = (bf16_t)f2bf(v[dt]); }
            }
        }
    }
    __syncthreads();
}
struct NsaLds { const float* kp[1024]; const float* vp[1024]; int dist[1024]; float lg[4][1024]; float imp[1032]; float sc[264]; int sel[16]; float qs[4][64]; int lut[128]; };
static_assert(2 * sizeof(NsaLds) <= RING_BYTES, "NSA LDS");
__device__ __forceinline__ float nsa_attend(int nk, NsaLds* L, const float* tbh, int tid) {
    for (int i = tid; i < nk; i += 256) {
        const int dd = L->dist[i];
        if (dd >= 0) { const float* k = L->kp[i]; float a0 = 0.f, a1 = 0.f, a2 = 0.f, a3 = 0.f;
            for (int d = 0; d < 64; d += 4) { const f32x4 kv = *(const f32x4*)(k + d);
#pragma unroll
                for (int e = 0; e < 4; ++e) { a0 += L->qs[0][d + e] * kv[e]; a1 += L->qs[1][d + e] * kv[e]; a2 += L->qs[2][d + e] * kv[e]; a3 += L->qs[3][d + e] * kv[e]; } }
            const int bk = L->lut[dd < 127 ? dd : 127];
            L->lg[0][i] = a0 + tbh[bk * 8 + 0]; L->lg[1][i] = a1 + tbh[bk * 8 + 1]; L->lg[2][i] = a2 + tbh[bk * 8 + 2]; L->lg[3][i] = a3 + tbh[bk * 8 + 3];
        } else { L->lg[0][i] = -3e38f; L->lg[1][i] = -3e38f; L->lg[2][i] = -3e38f; L->lg[3][i] = -3e38f; }
    }
    __syncthreads();
    { const int g = tid >> 6, lane = tid & 63;
        float mx = -3e38f; for (int i = lane; i < nk; i += 64) mx = fmaxf(mx, L->lg[g][i]);
        mx = wave_max(mx);
        float sm = 0.f; for (int i = lane; i < nk; i += 64) { const float l = L->lg[g][i]; sm += (l > -1e38f) ? __expf(l - mx) : 0.f; }
        sm = wave_sum(sm);
        const float inv = 1.f / fmaxf(sm, 1e-30f);
        for (int i = lane; i < nk; i += 64) { const float l = L->lg[g][i]; L->lg[g][i] = (l > -1e38f) ? __expf(l - mx) * inv : 0.f; }
    }
    __syncthreads();
    const int g = tid >> 6, d = tid & 63; float a = 0.f;
    for (int i = 0; i < nk; ++i) { const float p = L->lg[g][i]; if (p != 0.f) a += p * L->vp[i][d]; }
    return a;
}
template <int CHK>
__device__ __forceinline__ void p5_nsa(const Params& P, unsigned char* lds, int G) {
    const int tid = otid() & 255, hkv = otid() >> 8;
    NsaLds* L = (NsaLds*)lds + hkv;
    if (tid < 128) { int n = tid, bk; if (n < 16) bk = n; else { const float v = logf((float)n / 16.f) / 2.0794415416798357f * 16.f; bk = 16 + (int)v; if (bk > 31) bk = 31; } L->lut[tid] = bk; }
    const float* tbh = P.tb + hkv * 4;
    const float* dummy = P.qn;
    for (int it = blockIdx.x; it < (CHK ? 512 : SR); it += G) {
        const int m = CHK ? (it < 64 ? it : (it < 96 ? 1000 + it : (it * 613 + 7) & 16383)) : TP + it;
        const int seq = m < TP ? 0 : 1 + ((m - TP) >> 2), b = seq - 1;
        const int q_pos = m < TP ? m : PAST + ((m - TP) & 3);
        __syncthreads();
        L->qs[tid >> 6][tid & 63] = P.qn[(size_t)m * 512 + hkv * 256 + tid] * 0.125f;
        const int ncv = q_pos >= 31 ? min(NCMP, (q_pos - 31) / 16 + 1) : 0;
        const float* kcb = P.kcvc + (((size_t)seq * 2 + 0) * 2 + hkv) * 1024 * 64; const float* vcb = P.kcvc + (((size_t)seq * 2 + 1) * 2 + hkv) * 1024 * 64;
        for (int i = tid; i < ncv; i += 256) { L->kp[i] = kcb + (size_t)i * 64; L->vp[i] = vcb + (size_t)i * 64; L->dist[i] = q_pos - (16 * i + 31); }
        __syncthreads();
        const float oc = nsa_attend(ncv, L, tbh, tid);
        __syncthreads();
        for (int i = tid; i < 1032; i += 256) L->imp[i] = i < ncv ? (L->lg[0][i] + L->lg[1][i]) + (L->lg[2][i] + L->lg[3][i]) : 0.f;
        __syncthreads();
        const int ns = seq == 0 ? 256 : 257, cur = q_pos >> 6;
        for (int j = tid; j < ns; j += 256) {
            float s = 0.f;
            { const int i0 = 4 * j; if (i0 < NCMP) s += L->imp[i0]; if (i0 - 1 >= 0 && i0 - 1 < NCMP) s += L->imp[i0 - 1]; if (i0 + 1 < NCMP) s += L->imp[i0 + 1]; if (i0 < NCMP) s += L->imp[i0];
              if (i0 + 2 < NCMP) s += L->imp[i0 + 2]; if (i0 + 1 < NCMP) s += L->imp[i0 + 1]; if (i0 + 3 < NCMP) s += L->imp[i0 + 3]; if (i0 + 2 < NCMP) s += L->imp[i0 + 2]; }
            const bool forced = (j == 0) || (j == cur) || (j == cur - 1), valid = (j * 64 <= q_pos);
            if (forced) s = 1e9f; if (!valid) s = -1e9f;
            L->sc[j] = s;
        }
        __syncthreads();
        for (int j = tid; j < ns; j += 256) { const float sj = L->sc[j]; int rank = 0; for (int i = 0; i < ns; ++i) { const float si = L->sc[i]; rank += (si > sj || (si == sj && i < j)) ? 1 : 0; } if (rank < 16) L->sel[rank] = j; }
        __syncthreads();
        for (int i = tid; i < 1024; i += 256) {
            const int blk = L->sel[i >> 6], pos = blk * 64 + (i & 63); const int dd = q_pos - pos; L->dist[i] = dd;
            const float *k = dummy, *v = dummy;
            if (dd >= 0) {
                if (seq == 0) { k = P.kvw + (size_t)pos * 768 + (4 + hkv) * 64; v = k + 128; }
                else if (pos < PAST) { const int page = P.pt[b * NPAGES + (pos >> 7)]; k = P.cache + (((size_t)page * 128 + (pos & 127)) * 4 + 2) * 128 + hkv * 64; v = k + 128; }
                else { k = P.kvw + (size_t)(TP + 4 * b + (pos - PAST)) * 768 + (4 + hkv) * 64; v = k + 128; }
            }
            L->kp[i] = k; L->vp[i] = v;
        }
        __syncthreads();
        const float os = nsa_attend(1024, L, tbh, tid);
        __syncthreads();
        for (int i = tid; i < 513; i += 256) {
            const int pos = q_pos - 512 + i; int dd = 512 - i; const float *k = dummy, *v = dummy;
            if (pos < 0) dd = -1;
            else if (seq == 0) { k = P.kvw + (size_t)pos * 768 + (8 + hkv) * 64; v = k + 128; }
            else if (pos < PAST) { k = P.win_state + (((size_t)b * 512 + (pos - (PAST - 512))) * 2) * 128 + hkv * 64; v = k + 128; }
            else { k = P.kvw + (size_t)(TP + 4 * b + (pos - PAST)) * 768 + (8 + hkv) * 64; v = k + 128; }
            L->kp[i] = k; L->vp[i] = v; L->dist[i] = dd;
        }
        __syncthreads();
        const float ow = nsa_attend(513, L, tbh, tid);
        const int g = tid >> 6, d = tid & 63; const float* gt = P.gates + (size_t)m * 24 + (hkv * 4 + g) * 3;
        (CHK ? P.aochk : P.ao)[(size_t)m * D + 512 + (hkv * 4 + g) * 64 + d] = (bf16_t)f2bf(gt[0] * oc + gt[1] * os + gt[2] * ow);
        if (CHK) {
            __syncthreads();
            if (otid() < 64) { float se = 0.f, sr = 0.f;
                for (int i = otid(); i < 512; i += 64) { const float a = bf2f(P.ao[(size_t)m * D + 512 + i]), r = bf2f(P.aochk[(size_t)m * D + 512 + i]); se += (a - r) * (a - r); sr += r * r; }
                se = wave_sum(se); sr = wave_sum(sr);
                if (otid() == 0) { atomicAdd(P.ctl + 16, 1u); if (se > 0.0025f * sr) atomicAdd(P.ctl + 17, 1u); if (se > 0.0004f * sr) atomicAdd(P.ctl + 18, 1u); if (!(se <= 0.25f * sr)) atomicAdd(P.ctl + 19, 1u); } }
        }
    }
}

typedef short bf16x8 __attribute__((ext_vector_type(8)));
#define MFMA16(a, b, c) __builtin_amdgcn_mfma_f32_16x16x32_bf16((a), (b), (c), 0, 0, 0)
constexpr float LOG2E = 1.4426950408889634f;
__device__ __forceinline__ bf16x8 pack8(const float (&e)[8]) {
    v4u p; p.x = pg8::cvt_pk_bf16(e[0], e[1]); p.y = pg8::cvt_pk_bf16(e[2], e[3]); p.z = pg8::cvt_pk_bf16(e[4], e[5]); p.w = pg8::cvt_pk_bf16(e[6], e[7]);
    return __builtin_bit_cast(bf16x8, p);
}
__device__ __forceinline__ float dpp_xor1(float x) { return __builtin_bit_cast(float, __builtin_amdgcn_update_dpp(0, __builtin_bit_cast(int, x), 0xB1, 0xF, 0xF, true)); }
__device__ __forceinline__ float dpp_xor2(float x) { return __builtin_bit_cast(float, __builtin_amdgcn_update_dpp(0, __builtin_bit_cast(int, x), 0x4E, 0xF, 0xF, true)); }
__device__ __forceinline__ unsigned long long wave_max_u64(unsigned long long v) {
    unsigned lo = (unsigned)v, hi = (unsigned)(v >> 32);
#define WMX_STEP(ctrl, rmask) do { const unsigned lo2 = (unsigned)__builtin_amdgcn_update_dpp(0, (int)lo, ctrl, rmask, 0xf, false), hi2 = (unsigned)__builtin_amdgcn_update_dpp(0, (int)hi, ctrl, rmask, 0xf, false); \
        const bool gt = (hi2 > hi) || (hi2 == hi && lo2 > lo); lo = gt ? lo2 : lo; hi = gt ? hi2 : hi; } while (0)
    WMX_STEP(0x111, 0xf); WMX_STEP(0x112, 0xf); WMX_STEP(0x114, 0xf); WMX_STEP(0x118, 0xf); WMX_STEP(0x142, 0xa); WMX_STEP(0x143, 0xc);
#undef WMX_STEP
    lo = (unsigned)__builtin_amdgcn_readlane((int)lo, 63); hi = (unsigned)__builtin_amdgcn_readlane((int)hi, 63);
    return ((unsigned long long)hi << 32) | lo;
}
struct NsaBuf { const bf16_t *Qs, *Kc, *VcT, *Ksel, *VselT, *Kwin, *VwinT; };
template <bool GEN>
__device__ __forceinline__ void nsa_exp(const f32x4& sA, const f32x4& sB, float (&e)[8], float bfar, int dist0, int dstep, int dmax, const int* lut, const float* b2h) {
#pragma unroll
    for (int i = 0; i < 8; ++i) {
        const float s = i < 4 ? sA[i] : sB[i - 4];
        if (GEN) { const int dist = dist0 - i * dstep; const bool ok = dist >= 0 && dist <= dmax; const int dd = dist < 0 ? 0 : (dist > 127 ? 127 : dist);
            const float l = s + b2h[lut[dd] * 8]; e[i] = ok ? __builtin_amdgcn_exp2f(l) : 0.f; }
        else e[i] = __builtin_amdgcn_exp2f(s + bfar);
    }
}
constexpr int NSA_WB = 18432, NSA_LUT = NWAVES * NSA_WB;
static_assert(NSA_LUT + 2048 + NWAVES * 512 <= MISC_OFF, "NSA LDS map");
constexpr int NCT = 2, QT = 4 * NCT;
__device__ __forceinline__ void nsa_unit(const Params& P, const NsaBuf& B, int unit, float* sc, int* selL, const int* lut, const float* b2) {
    unsigned char* slotK = (unsigned char*)sc; unsigned char* slotV = slotK + 9216;
    const int lane = otid() & 63, c = lane & 15, rq = lane >> 4, g = c & 3, qq = c >> 2;
    const int hkv = unit & 1, t0 = (unit >> 1) * QT;
    const float* b2h = b2 + hkv * 4 + g; const float bfar = b2h[31 * 8];
    const int krow = 8 * (c >> 2) + (c & 3);
    bf16x8 Qf[NCT][2];
#pragma unroll
    for (int ct = 0; ct < NCT; ++ct)
#pragma unroll
        for (int ks = 0; ks < 2; ++ks) Qf[ct][ks] = *(const bf16x8*)(B.Qs + (size_t)(t0 + ct * 4 + qq) * 512 + hkv * 256 + g * 64 + ks * 32 + rq * 8);
    f32x4 O[4][NCT];
#pragma unroll
    for (int dt = 0; dt < 4; ++dt)
#pragma unroll
        for (int ct = 0; ct < NCT; ++ct) O[dt][ct] = (f32x4){0.f, 0.f, 0.f, 0.f};
    const f32x4 zero4 = (f32x4){0.f, 0.f, 0.f, 0.f};
    const float* gat = P.gates + (size_t)(t0 + qq) * 24 + (hkv * 4 + g) * 3;
    {
        float Z[NCT]; for (int ct = 0; ct < NCT; ++ct) Z[ct] = 0.f;
        const bf16_t* Kb = B.Kwin + (size_t)hkv * TP * 64; const bf16_t* Vb = B.VwinT + (size_t)hkv * 256 * 4096;
        struct Raw16 { v4u k[8], v[8]; };
#define BLK_GLOAD(R_, jj) do { const unsigned char* kp_ = (const unsigned char*)Kb + (size_t)(jj) * 8192 + lane * 16; const unsigned char* vp_ = (const unsigned char*)Vb + (size_t)(jj) * 8192 + lane * 16; \
        _Pragma("unroll") for (int n = 0; n < 8; ++n) { R_.k[n] = *(const v4u*)(kp_ + n * 1024); R_.v[n] = *(const v4u*)(vp_ + n * 1024); } } while (0)
#define BLK_STORE(R_) do { _Pragma("unroll") for (int n = 0; n < 8; ++n) { const int k_ = n * 8 + (lane >> 3), kk_ = k_ & 31, ir_ = (k_ & 32) + ((kk_ >> 2) & 1) * 16 + (((kk_ >> 3) << 2) | (kk_ & 3)); \
        *(v4u*)(slotK + ir_ * 144 + (lane & 7) * 16) = R_.k[n]; *(v4u*)(slotV + (n * 8 + (lane >> 3)) * 144 + (lane & 7) * 16) = R_.v[n]; } } while (0)
        int jb0 = t0 - 512; if (jb0 < 0) jb0 = 0; jb0 >>= 6; const int jb1 = (t0 + QT - 1) >> 6;
        Raw16 R;
        BLK_GLOAD(R, jb0);
#pragma unroll 1
        for (int jb = jb0; jb <= jb1; ++jb) {
            BLK_STORE(R);
            if (jb < jb1) BLK_GLOAD(R, jb + 1);
            const bool gen = (64 * jb + 63 > t0 - 113) || (64 * jb < t0 + QT - 1 - 512);
#pragma unroll
            for (int hh = 0; hh < 2; ++hh) {
                const int k0 = 64 * jb + 32 * hh; bf16x8 KA[2], KB[2], Vf[4];
#pragma unroll
                for (int ks = 0; ks < 2; ++ks) { KA[ks] = *(const bf16x8*)(slotK + (32 * hh + c) * 144 + (ks * 4 + rq) * 16); KB[ks] = *(const bf16x8*)(slotK + (32 * hh + 16 + c) * 144 + (ks * 4 + rq) * 16); }
#pragma unroll
                for (int dt = 0; dt < 4; ++dt) Vf[dt] = *(const bf16x8*)(slotV + (dt * 16 + c) * 144 + (4 * hh + rq) * 16);
#pragma unroll
                for (int ct = 0; ct < NCT; ++ct) {
                    f32x4 sA = MFMA16(KA[0], Qf[ct][0], zero4); sA = MFMA16(KA[1], Qf[ct][1], sA);
                    f32x4 sB = MFMA16(KB[0], Qf[ct][0], zero4); sB = MFMA16(KB[1], Qf[ct][1], sB);
                    float e[8];
                    if (gen) nsa_exp<true>(sA, sB, e, bfar, (t0 + ct * 4 + qq) - (k0 + 8 * rq), 1, 512, lut, b2h); else nsa_exp<false>(sA, sB, e, bfar, 0, 0, 0, lut, b2h);
                    Z[ct] += ((e[0] + e[1]) + (e[2] + e[3])) + ((e[4] + e[5]) + (e[6] + e[7]));
                    const bf16x8 Pf = pack8(e);
#pragma unroll
                    for (int dt = 0; dt < 4; ++dt) O[dt][ct] = MFMA16(Vf[dt], Pf, O[dt][ct]);
                }
            }
        }
#undef BLK_GLOAD
#undef BLK_STORE
#pragma unroll
        for (int ct = 0; ct < NCT; ++ct) { float z = Z[ct]; z += __shfl_xor(z, 16); z += __shfl_xor(z, 32); const float sc_ = gat[ct * 96 + 2] / fmaxf(z, 1e-30f);
#pragma unroll
            for (int dt = 0; dt < 4; ++dt) O[dt][ct] = O[dt][ct] * sc_; }
    }
    {
        const bf16_t* Kb = B.Kc + (size_t)hkv * 1024 * 64; const bf16_t* Vb = B.VcT + (size_t)hkv * 64 * 1024;
        const int ncv_max = (t0 + QT - 1 >= 31) ? min(NCMP, (t0 + QT - 1 - 31) / 16 + 1) : 0, nsteps = (ncv_max + 31) >> 5;
        float Z[NCT]; for (int ct = 0; ct < NCT; ++ct) Z[ct] = 0.f;
        unsigned char* cK = (unsigned char*)sc + 8192; unsigned char* cV = cK + 4608;
        struct Raw8 { v4u k[4], v[4]; };
#define CMP_GLOAD(R_, ss, withv) do { const unsigned char* kp_ = (const unsigned char*)Kb + (size_t)(ss) * 4096 + lane * 16; const unsigned char* vp_ = (const unsigned char*)Vb + (size_t)(ss) * 4096 + lane * 16; \
        _Pragma("unroll") for (int n = 0; n < 4; ++n) { R_.k[n] = *(const v4u*)(kp_ + n * 1024); if (withv) R_.v[n] = *(const v4u*)(vp_ + n * 1024); } } while (0)
#define CMP_STORE(R_, withv) do { _Pragma("unroll") for (int n = 0; n < 4; ++n) { const int kk_ = n * 8 + (lane >> 3), ir_ = ((kk_ >> 2) & 1) * 16 + (((kk_ >> 3) << 2) | (kk_ & 3)); \
        *(v4u*)(cK + ir_ * 144 + (lane & 7) * 16) = R_.k[n]; if (withv) *(v4u*)(cV + (n * 16 + (lane >> 2)) * 80 + (lane & 3) * 16) = R_.v[n]; } } while (0)
#define CMP_FRAGK(KA_, KB_) do { _Pragma("unroll") for (int ks = 0; ks < 2; ++ks) { KA_[ks] = *(const bf16x8*)(cK + c * 144 + (ks * 4 + rq) * 16); KB_[ks] = *(const bf16x8*)(cK + (16 + c) * 144 + (ks * 4 + rq) * 16); } } while (0)
#define CMP_FRAGV(Vf_) do { _Pragma("unroll") for (int dt = 0; dt < 4; ++dt) Vf_[dt] = *(const bf16x8*)(cV + (dt * 16 + c) * 80 + rq * 16); } while (0)
        {
        Raw8 R;
        if (nsteps > 0) CMP_GLOAD(R, 0, false);
#pragma unroll 1
        for (int s = 0; s < nsteps; ++s) {
            const int n0 = 32 * s;
            CMP_STORE(R, false);
            if (s + 1 < nsteps) CMP_GLOAD(R, s + 1, false);
            bf16x8 KA[2], KB[2]; CMP_FRAGK(KA, KB);
            const bool gen = 16 * (n0 + 31) + 31 + 113 > t0;
#pragma unroll
            for (int ct = 0; ct < NCT; ++ct) {
                f32x4 sA = MFMA16(KA[0], Qf[ct][0], zero4); sA = MFMA16(KA[1], Qf[ct][1], sA);
                f32x4 sB = MFMA16(KB[0], Qf[ct][0], zero4); sB = MFMA16(KB[1], Qf[ct][1], sB);
                float e[8];
                if (gen) nsa_exp<true>(sA, sB, e, bfar, (t0 + ct * 4 + qq) - 31 - 16 * (n0 + 8 * rq), 16, 1 << 30, lut, b2h); else nsa_exp<false>(sA, sB, e, bfar, 0, 0, 0, lut, b2h);
                Z[ct] += ((e[0] + e[1]) + (e[2] + e[3])) + ((e[4] + e[5]) + (e[6] + e[7]));
            }
        }
        }
        float inv[NCT], gs[NCT], carry[NCT];
#pragma unroll
        for (int ct = 0; ct < NCT; ++ct) { float z = Z[ct]; z += __shfl_xor(z, 16); z += __shfl_xor(z, 32); inv[ct] = 1.f / fmaxf(z, 1e-30f); gs[ct] = gat[ct * 96 + 0] * inv[ct]; carry[ct] = 0.f; }
        Raw8 R;
        if (nsteps > 0) CMP_GLOAD(R, 0, true);
#pragma unroll 1
        for (int s = 0; s < nsteps; ++s) {
            const int n0 = 32 * s;
            CMP_STORE(R, true);
            if (s + 1 < nsteps) CMP_GLOAD(R, s + 1, true);
            bf16x8 KA[2], KB[2], Vf[4]; CMP_FRAGK(KA, KB); CMP_FRAGV(Vf);
            const bool gen = 16 * (n0 + 31) + 31 + 113 > t0;
#pragma unroll
            for (int ct = 0; ct < NCT; ++ct) {
                f32x4 sA = MFMA16(KA[0], Qf[ct][0], zero4); sA = MFMA16(KA[1], Qf[ct][1], sA);
                f32x4 sB = MFMA16(KB[0], Qf[ct][0], zero4); sB = MFMA16(KB[1], Qf[ct][1], sB);
                float e[8], pg[8], im[8];
                if (gen) nsa_exp<true>(sA, sB, e, bfar, (t0 + ct * 4 + qq) - 31 - 16 * (n0 + 8 * rq), 16, 1 << 30, lut, b2h); else nsa_exp<false>(sA, sB, e, bfar, 0, 0, 0, lut, b2h);
#pragma unroll
                for (int i = 0; i < 8; ++i) { pg[i] = e[i] * gs[ct]; float x = e[i] * inv[ct]; x += dpp_xor1(x); x += dpp_xor2(x); im[i] = x; }
                const bf16x8 Pf = pack8(pg);
#pragma unroll
                for (int dt = 0; dt < 4; ++dt) O[dt][ct] = MFMA16(Vf[dt], Pf, O[dt][ct]);
                const float up = __shfl(im[7], (lane + 48) & 63);
                const float m1 = rq == 0 ? carry[ct] : up;
                carry[ct] = __shfl(im[7], 48 + c);
                if (g == 0) { const int J0 = (n0 >> 2) + 2 * rq; float* scq = sc + (ct * 4 + qq) * 256 + J0;
                    scq[0] = m1 + 2.f * ((im[0] + im[1]) + im[2]) + im[3]; scq[1] = im[3] + 2.f * ((im[4] + im[5]) + im[6]) + im[7]; }
            }
        }
#undef CMP_GLOAD
#undef CMP_STORE
#undef CMP_FRAGK
#undef CMP_FRAGV
        if (nsteps < 32) { const int w = 256 - 8 * nsteps; for (int i = lane; i < QT * w; i += 64) sc[(i / w) * 256 + 8 * nsteps + (i % w)] = 0.f; }
    }
    LDS_WAIT(); asm volatile("" ::: "memory");
#pragma unroll 1
    for (int qi = 0; qi < QT; ++qi) {
        const int q_pos = t0 + qi, cur = q_pos >> 6;
        if (cur < 16) { if (lane < 16) selL[qi * 16 + lane] = lane <= cur ? lane : -1; }
        else {
            unsigned long long k[4];
#pragma unroll
            for (int i = 0; i < 4; ++i) { const int J = lane + 64 * i; const bool valid = J >= 1 && J <= cur - 2; k[i] = valid ? (((unsigned long long)__float_as_uint(sc[qi * 256 + J]) << 32) | (0xFFFFFFFFu - (unsigned)J)) : 0ull; }
            if (lane == 0) { selL[qi * 16 + 0] = 0; selL[qi * 16 + 1] = cur - 1; selL[qi * 16 + 2] = cur; }
#pragma unroll 1
            for (int r = 0; r < 13; ++r) {
                unsigned long long m = k[0] > k[1] ? k[0] : k[1]; const unsigned long long m2 = k[2] > k[3] ? k[2] : k[3]; m = m > m2 ? m : m2;
                const unsigned long long wm = wave_max_u64(m);
                if (lane == 0) selL[qi * 16 + 3 + r] = (int)(0xFFFFFFFFu - (unsigned)wm);
#pragma unroll
                for (int i = 0; i < 4; ++i) k[i] = (k[i] == wm) ? 0ull : k[i];
            }
        }
    }
    LDS_WAIT(); asm volatile("" ::: "memory");
    {
        const bf16_t* Kb = B.Ksel + (size_t)hkv * TP * 64; const bf16_t* Vb = B.VselT + (size_t)hkv * 256 * 4096;
        const bf16x8 zq = (bf16x8){0, 0, 0, 0, 0, 0, 0, 0};
#pragma unroll
        for (int ct = 0; ct < NCT; ++ct) {
#pragma unroll 1
            for (int q2 = 0; q2 < 4; ++q2) {
                const int qi = ct * 4 + q2, q_pos = t0 + qi, cur = q_pos >> 6;
                const bool mine = (qq == q2);
                const bf16x8 Q0 = mine ? Qf[ct][0] : zq, Q1 = mine ? Qf[ct][1] : zq;
                f32x4 Os[4] = {zero4, zero4, zero4, zero4}; float Zs = 0.f;
                struct SelRaw { v4u k[8], v[8]; };
#define SEL_GLOAD(R_, jj) do { const unsigned char* kp_ = (const unsigned char*)Kb + (size_t)(jj) * 8192 + lane * 16; const unsigned char* vp_ = (const unsigned char*)Vb + (size_t)(jj) * 8192 + lane * 16; \
        _Pragma("unroll") for (int n = 0; n < 8; ++n) { R_.k[n] = *(const v4u*)(kp_ + n * 1024); R_.v[n] = *(const v4u*)(vp_ + n * 1024); } } while (0)
#define SEL_STORE(R_) do { _Pragma("unroll") for (int n = 0; n < 8; ++n) { const int k_ = n * 8 + (lane >> 3), kk_ = k_ & 31, ir_ = (k_ & 32) + ((kk_ >> 2) & 1) * 16 + (((kk_ >> 3) << 2) | (kk_ & 3)); \
        *(v4u*)(slotK + ir_ * 144 + (lane & 7) * 16) = R_.k[n]; *(v4u*)(slotV + (n * 8 + (lane >> 3)) * 144 + (lane & 7) * 16) = R_.v[n]; } } while (0)
#define SEL_COMPUTE(jj) do { const bool gen = (jj) >= cur - 2; _Pragma("unroll") for (int hh = 0; hh < 2; ++hh) { const int k0 = 64 * (jj) + 32 * hh; bf16x8 KA[2], KB[2], Vf[4]; \
        _Pragma("unroll") for (int ks = 0; ks < 2; ++ks) { KA[ks] = *(const bf16x8*)(slotK + (32 * hh + c) * 144 + (ks * 4 + rq) * 16); KB[ks] = *(const bf16x8*)(slotK + (32 * hh + 16 + c) * 144 + (ks * 4 + rq) * 16); } \
        _Pragma("unroll") for (int dt = 0; dt < 4; ++dt) Vf[dt] = *(const bf16x8*)(slotV + (dt * 16 + c) * 144 + (4 * hh + rq) * 16); \
        f32x4 sA = MFMA16(KA[0], Q0, zero4); sA = MFMA16(KA[1], Q1, sA); f32x4 sB = MFMA16(KB[0], Q0, zero4); sB = MFMA16(KB[1], Q1, sB); \
        float e[8]; if (gen) nsa_exp<true>(sA, sB, e, bfar, q_pos - (k0 + 8 * rq), 1, 1 << 30, lut, b2h); else nsa_exp<false>(sA, sB, e, bfar, 0, 0, 0, lut, b2h); \
        Zs += ((e[0] + e[1]) + (e[2] + e[3])) + ((e[4] + e[5]) + (e[6] + e[7])); const bf16x8 Pf = pack8(e); \
        _Pragma("unroll") for (int dt = 0; dt < 4; ++dt) Os[dt] = MFMA16(Vf[dt], Pf, Os[dt]); } } while (0)
                const int nb = cur < 16 ? cur + 1 : 16;
                SelRaw R;
                int j = __builtin_amdgcn_readfirstlane(selL[qi * 16]);
                SEL_GLOAD(R, j);
#pragma unroll 1
                for (int bi = 0; bi < nb; ++bi) {
                    SEL_STORE(R);
                    const int jn = __builtin_amdgcn_readfirstlane(selL[qi * 16 + (bi + 1 < nb ? bi + 1 : bi)]);
                    if (bi + 1 < nb) SEL_GLOAD(R, jn);
                    SEL_COMPUTE(j);
                    j = jn;
                }
#undef SEL_GLOAD
#undef SEL_STORE
#undef SEL_COMPUTE
                Zs += __shfl_xor(Zs, 16); Zs += __shfl_xor(Zs, 32);
                const float sc_ = mine ? gat[ct * 96 + 1] / fmaxf(Zs, 1e-30f) : 0.f;
#pragma unroll
                for (int dt = 0; dt < 4; ++dt) O[dt][ct] = O[dt][ct] + Os[dt] * sc_;
            }
        }
    }
#pragma unroll
    for (int ct = 0; ct < NCT; ++ct)
#pragma unroll
        for (int dt = 0; dt < 4; ++dt) { v2u w; w.x = pg8::cvt_pk_bf16(O[dt][ct][0], O[dt][ct][1]); w.y = pg8::cvt_pk_bf16(O[dt][ct][2], O[dt][ct][3]);
            *(v2u*)(P.ao + (size_t)(t0 + ct * 4 + qq) * D + 512 + (hkv * 4 + g) * 64 + dt * 16 + 4 * rq) = w; }
}

__device__ __forceinline__ void nsa_unit_sample(const Params& P, int unit, float* sc, int* selL, const int* lut, const float* b2) {
    const int lane = otid() & 63, c = lane & 15, rq = lane >> 4, g = c & 3, qq = c >> 2;
    const int hkv = unit & 1, b = unit >> 1, bh = b * 2 + hkv;
    const int m = TP + b * 4 + qq, qpos = PAST + qq;
    const float* b2h = b2 + hkv * 4 + g; const float bfar = b2h[31 * 8];
    const int krow = 8 * (c >> 2) + (c & 3);
    bf16x8 Qf[2];
#pragma unroll
    for (int ks = 0; ks < 2; ++ks) Qf[ks] = *(const bf16x8*)(P.Qs + (size_t)m * 512 + hkv * 256 + g * 64 + ks * 32 + rq * 8);
    const f32x4 zero4 = (f32x4){0.f, 0.f, 0.f, 0.f};
    f32x4 O[4] = {zero4, zero4, zero4, zero4};
    const float* gat = P.gates + (size_t)m * 24 + (hkv * 4 + g) * 3;
    {
        const bf16_t* Kb = P.KwinS + (size_t)bh * 544 * 64; const bf16_t* Vb = P.VwinST + (size_t)bh * 64 * 544;
        float Z = 0.f;
#pragma unroll 1
        for (int k0 = 0; k0 < 544; k0 += 32) {
            bf16x8 KA[2], KB[2], Vf[4];
#pragma unroll
            for (int ks = 0; ks < 2; ++ks) { KA[ks] = *(const bf16x8*)(Kb + (size_t)(k0 + krow) * 64 + ks * 32 + rq * 8); KB[ks] = *(const bf16x8*)(Kb + (size_t)(k0 + krow + 4) * 64 + ks * 32 + rq * 8); }
#pragma unroll
            for (int dt = 0; dt < 4; ++dt) Vf[dt] = *(const bf16x8*)(Vb + (size_t)(dt * 16 + c) * 544 + k0 + rq * 8);
            f32x4 sA = MFMA16(KA[0], Qf[0], zero4); sA = MFMA16(KA[1], Qf[1], sA); f32x4 sB = MFMA16(KB[0], Qf[0], zero4); sB = MFMA16(KB[1], Qf[1], sB);
            float e[8]; nsa_exp<true>(sA, sB, e, bfar, 512 + qq - (k0 + 8 * rq), 1, 512, lut, b2h);
            Z += ((e[0] + e[1]) + (e[2] + e[3])) + ((e[4] + e[5]) + (e[6] + e[7]));
            const bf16x8 Pf = pack8(e);
#pragma unroll
            for (int dt = 0; dt < 4; ++dt) O[dt] = MFMA16(Vf[dt], Pf, O[dt]);
        }
        Z += __shfl_xor(Z, 16); Z += __shfl_xor(Z, 32); const float sc_ = gat[2] / fmaxf(Z, 1e-30f);
#pragma unroll
        for (int dt = 0; dt < 4; ++dt) O[dt] = O[dt] * sc_;
    }
    {
        const bf16_t* Kb = P.Kc + ((size_t)(b + 1) * 2 + hkv) * 1024 * 64; const bf16_t* Vb = P.VcT + ((size_t)(b + 1) * 2 + hkv) * 64 * 1024;
        float Z = 0.f;
#pragma unroll 1
        for (int s = 0; s < 32; ++s) {
            const int n0 = 32 * s; bf16x8 KA[2], KB[2];
#pragma unroll
            for (int ks = 0; ks < 2; ++ks) { KA[ks] = *(const bf16x8*)(Kb + (size_t)(n0 + krow) * 64 + ks * 32 + rq * 8); KB[ks] = *(const bf16x8*)(Kb + (size_t)(n0 + krow + 4) * 64 + ks * 32 + rq * 8); }
            f32x4 sA = MFMA16(KA[0], Qf[0], zero4); sA = MFMA16(KA[1], Qf[1], sA); f32x4 sB = MFMA16(KB[0], Qf[0], zero4); sB = MFMA16(KB[1], Qf[1], sB);
            float e[8]; nsa_exp<true>(sA, sB, e, bfar, qpos - 31 - 16 * (n0 + 8 * rq), 16, 1 << 30, lut, b2h);
            Z += ((e[0] + e[1]) + (e[2] + e[3])) + ((e[4] + e[5]) + (e[6] + e[7]));
        }
        Z += __shfl_xor(Z, 16); Z += __shfl_xor(Z, 32);
        const float inv = 1.f / fmaxf(Z, 1e-30f), gs = gat[0] * inv; float carry = 0.f;
#pragma unroll 1
        for (int s = 0; s < 32; ++s) {
            const int n0 = 32 * s; bf16x8 KA[2], KB[2], Vf[4];
#pragma unroll
            for (int ks = 0; ks < 2; ++ks) { KA[ks] = *(const bf16x8*)(Kb + (size_t)(n0 + krow) * 64 + ks * 32 + rq * 8); KB[ks] = *(const bf16x8*)(Kb + (size_t)(n0 + krow + 4) * 64 + ks * 32 + rq * 8); }
#pragma unroll
            for (int dt = 0; dt < 4; ++dt) Vf[dt] = *(const bf16x8*)(Vb + ((size_t)s * 64 + dt * 16 + c) * 32 + rq * 8);
            f32x4 sA = MFMA16(KA[0], Qf[0], zero4); sA = MFMA16(KA[1], Qf[1], sA); f32x4 sB = MFMA16(KB[0], Qf[0], zero4); sB = MFMA16(KB[1], Qf[1], sB);
            float e[8], pg[8], im[8]; nsa_exp<true>(sA, sB, e, bfar, qpos - 31 - 16 * (n0 + 8 * rq), 16, 1 << 30, lut, b2h);
#pragma unroll
            for (int i = 0; i < 8; ++i) { pg[i] = e[i] * gs; float x = e[i] * inv; x += dpp_xor1(x); x += dpp_xor2(x); im[i] = x; }
            const bf16x8 Pf = pack8(pg);
#pragma unroll
            for (int dt = 0; dt < 4; ++dt) O[dt] = MFMA16(Vf[dt], Pf, O[dt]);
            const float up = __shfl(im[7], (lane + 48) & 63); const float m1 = rq == 0 ? carry : up; carry = __shfl(im[7], 48 + c);
            if (g == 0) { const int J0 = (n0 >> 2) + 2 * rq; float* scq = sc + qq * 256 + J0;
                scq[0] = m1 + 2.f * ((im[0] + im[1]) + im[2]) + im[3]; scq[1] = im[3] + 2.f * ((im[4] + im[5]) + im[6]) + im[7]; }
        }
    }
    LDS_WAIT(); asm volatile("" ::: "memory");
#pragma unroll 1
    for (int qi = 0; qi < 4; ++qi) {
        unsigned long long k[4];
#pragma unroll
        for (int i = 0; i < 4; ++i) { const int J = lane + 64 * i; const bool valid = J >= 1 && J <= 254; k[i] = valid ? (((unsigned long long)__float_as_uint(sc[qi * 256 + J]) << 32) | (0xFFFFFFFFu - (unsigned)J)) : 0ull; }
        if (lane == 0) { selL[qi * 16 + 0] = 0; selL[qi * 16 + 1] = 255; selL[qi * 16 + 2] = 256; }
#pragma unroll 1
        for (int r = 0; r < 13; ++r) {
            unsigned long long mx = k[0] > k[1] ? k[0] : k[1]; const unsigned long long m2 = k[2] > k[3] ? k[2] : k[3]; mx = mx > m2 ? mx : m2;
            const unsigned long long wm = wave_max_u64(mx);
            if (lane == 0) selL[qi * 16 + 3 + r] = (int)(0xFFFFFFFFu - (unsigned)wm);
#pragma unroll
            for (int i = 0; i < 4; ++i) k[i] = (k[i] == wm) ? 0ull : k[i];
        }
    }
    LDS_WAIT(); asm volatile("" ::: "memory");
    {
        const bf16x8 zq = (bf16x8){0, 0, 0, 0, 0, 0, 0, 0};
        const bf16_t* Kn = P.KselSn + (size_t)bh * 4096; const bf16_t* Vn = P.VselSTn + (size_t)bh * 4096;
#pragma unroll 1
        for (int q2 = 0; q2 < 4; ++q2) {
            const int q_pos = PAST + q2; const bool mine = (qq == q2);
            const bf16x8 Q0 = mine ? Qf[0] : zq, Q1 = mine ? Qf[1] : zq;
            f32x4 Os[4] = {zero4, zero4, zero4, zero4}; float Zs = 0.f;
#pragma unroll 1
            for (int bi = 0; bi < 16; ++bi) {
                const int j = __builtin_amdgcn_readfirstlane(selL[q2 * 16 + bi]);
#pragma unroll 1
                for (int h = 0; h < 2; ++h) {
                    bf16x8 KA[2], KB[2], Vf[4];
                    if (j == 256) {
#pragma unroll
                        for (int ks = 0; ks < 2; ++ks) { KA[ks] = *(const bf16x8*)(Kn + (32 * h + krow) * 64 + ks * 32 + rq * 8); KB[ks] = *(const bf16x8*)(Kn + (32 * h + krow + 4) * 64 + ks * 32 + rq * 8); }
#pragma unroll
                        for (int dt = 0; dt < 4; ++dt) Vf[dt] = *(const bf16x8*)(Vn + (dt * 16 + c) * 64 + 32 * h + rq * 8);
                    } else {
                        const int page = P.pt[b * NPAGES + (j >> 1)]; const size_t rowb = (size_t)page * 128 + (j & 1) * 64 + 32 * h;
#pragma unroll
                        for (int ks = 0; ks < 2; ++ks) {
                            const float* pa = P.cache + ((rowb + krow) * 4 + 2) * 128 + hkv * 64 + ks * 32 + rq * 8; const float* pb = pa + 4 * 512;
                            const f32x4 a0 = *(const f32x4*)pa, a1 = *(const f32x4*)(pa + 4), b0 = *(const f32x4*)pb, b1 = *(const f32x4*)(pb + 4);
                            v4u wa, wb; wa.x = pk2(a0.x, a0.y); wa.y = pk2(a0.z, a0.w); wa.z = pk2(a1.x, a1.y); wa.w = pk2(a1.z, a1.w); wb.x = pk2(b0.x, b0.y); wb.y = pk2(b0.z, b0.w); wb.z = pk2(b1.x, b1.y); wb.w = pk2(b1.z, b1.w);
                            KA[ks] = __builtin_bit_cast(bf16x8, wa); KB[ks] = __builtin_bit_cast(bf16x8, wb); }
#pragma unroll
                        for (int dt = 0; dt < 4; ++dt) { const float* pv = P.cache + ((rowb + 8 * rq) * 4 + 3) * 128 + hkv * 64 + dt * 16 + c; float x[8];
#pragma unroll
                            for (int jj = 0; jj < 8; ++jj) x[jj] = pv[(size_t)jj * 512];
                            v4u w; w.x = pk2(x[0], x[1]); w.y = pk2(x[2], x[3]); w.z = pk2(x[4], x[5]); w.w = pk2(x[6], x[7]); Vf[dt] = __builtin_bit_cast(bf16x8, w); }
                    }
                    f32x4 sA = MFMA16(KA[0], Q0, zero4); sA = MFMA16(KA[1], Q1, sA); f32x4 sB = MFMA16(KB[0], Q0, zero4); sB = MFMA16(KB[1], Q1, sB);
                    float e[8];
                    if (j >= 254) nsa_exp<true>(sA, sB, e, bfar, q_pos - (64 * j + 32 * h + 8 * rq), 1, 1 << 30, lut, b2h); else nsa_exp<false>(sA, sB, e, bfar, 0, 0, 0, lut, b2h);
                    Zs += ((e[0] + e[1]) + (e[2] + e[3])) + ((e[4] + e[5]) + (e[6] + e[7]));
                    const bf16x8 Pf = pack8(e);
#pragma unroll
                    for (int dt = 0; dt < 4; ++dt) Os[dt] = MFMA16(Vf[dt], Pf, Os[dt]);
                }
            }
            Zs += __shfl_xor(Zs, 16); Zs += __shfl_xor(Zs, 32);
            const float sc_ = mine ? gat[1] / fmaxf(Zs, 1e-30f) : 0.f;
#pragma unroll
            for (int dt = 0; dt < 4; ++dt) O[dt] = O[dt] + Os[dt] * sc_;
        }
    }
#pragma unroll
    for (int dt = 0; dt < 4; ++dt) { v2u w; w.x = pg8::cvt_pk_bf16(O[dt][0], O[dt][1]); w.y = pg8::cvt_pk_bf16(O[dt][2], O[dt][3]);
        *(v2u*)(P.ao + (size_t)m * D + 512 + (hkv * 4 + g) * 64 + dt * 16 + 4 * rq) = w; }
}
__device__ __forceinline__ void p5_nsa_mfma(const Params& P, unsigned char* lds, int G, int rep) {
    int* lut = (int*)(lds + NSA_LUT); float* b2 = (float*)(lds + NSA_LUT + 512);
    const int tid = otid(), wave = __builtin_amdgcn_readfirstlane(tid >> 6), lane = tid & 63;
    if (tid < 128) { int n = tid, bk; if (n < 16) bk = n; else { const float v = logf((float)n / 16.f) / 2.0794415416798357f * 16.f; bk = 16 + (int)v; if (bk > 31) bk = 31; } lut[tid] = bk; }
    if (tid < 256) b2[tid] = P.tb[tid] * LOG2E;
    __syncthreads();
    float* sc = (float*)(lds + wave * NSA_WB); int* selL = (int*)(lds + NSA_LUT + 2048 + wave * 512);
    const NsaBuf B{P.Qs, P.Kc, P.VcT, P.Ksel, P.VselT, P.Kwin, P.VwinT};
    constexpr int NSU = 32, NPU = TP / QT;
    const int pref = (int)((xb_xcc_id() >> 2) & 1u);
    int q = pref, dry = 0;
    for (;;) {
        unsigned u = 0; if (lane == 0) u = atomicAdd(P.ctl + 32 + 2 * rep + q, 1u);
        u = (unsigned)__builtin_amdgcn_readfirstlane((int)u);
        if (u >= (unsigned)(NSU + NPU)) { if (++dry == 2) break; q ^= 1; continue; }
        if (u < NSU) nsa_unit_sample(P, ((int)u << 1) | q, sc, selL, lut, b2);
        else nsa_unit(P, B, ((NPU - 1 - ((int)u - NSU)) << 1) | q, sc, selL, lut, b2);
    }
    __syncthreads();
}
template <int MODE>
__device__ __forceinline__ void hg_item(const Params& P, float* L, int idx, int h, int tid) {
    float *fl = L, *vl = L + 128, *ql = L + 256, *red = L + 384;
    const int v = tid & 127, dh = tid >> 7;
    float S[64];
    if (MODE == 0) {
#pragma unroll
        for (int j = 0; j < 64; ++j) S[j] = 0.f;
    } else if (MODE == 1) {
#pragma unroll
        for (int j = 0; j < 64; ++j) S[j] = P.Sst[(((size_t)idx * 8 + h) * 128 + dh * 64 + j) * 128 + v];
    } else {
#pragma unroll
        for (int j = 0; j < 64; ++j) S[j] = P.hg_state[(((size_t)idx * 8 + h) * 128 + dh * 64 + j) * 128 + v];
    }
    float Dt = 1.f; const float lbv = P.lbv[h * 128 + v];
    const int t0 = MODE == 2 ? TP + 4 * idx : idx * 256, nt = MODE == 2 ? 4 : 256;
    for (int t = t0; t < t0 + nt; ++t) {
        const float* row = P.hgp + (size_t)t * 4096;
        if (dh == 0) { const float f = lbv + (1.f - lbv) * sigmoidf_(row[1024 + h * 128 + v]); fl[v] = f; Dt *= f; if (MODE != 0) ql[v] = row[h * 128 + v]; } else vl[v] = row[2048 + h * 128 + v];
        __syncthreads();
        const float vv = vl[v]; float part = 0.f;
#pragma unroll
        for (int j = 0; j < 64; ++j) { const float f = fl[dh * 64 + j]; S[j] = f * S[j] + (1.f - f) * vv; if (MODE != 0) part += ql[dh * 64 + j] * S[j]; }
        if (MODE != 0) red[dh * 128 + v] = part;
        __syncthreads();
        if (MODE != 0 && dh == 0) P.og[(size_t)t * D + h * 128 + v] = red[v] + red[128 + v];
    }
    if (MODE == 0) {
#pragma unroll
        for (int j = 0; j < 64; ++j) P.dS[(((size_t)idx * 8 + h) * 128 + dh * 64 + j) * 128 + v] = S[j];
        if (dh == 0) P.Dtot[((size_t)idx * 8 + h) * 128 + v] = Dt;
    } else if (MODE == 2) {
#pragma unroll
        for (int j = 0; j < 64; ++j) P.out[OFF_HGS + (((size_t)idx * 8 + h) * 128 + dh * 64 + j) * 128 + v] = S[j];
    }
}
template <int MODE>
__device__ __forceinline__ void hg_phase(const Params& P, unsigned char* lds, int G) {
    const int tid = otid() & 255, half = otid() >> 8;
    float* L = (float*)lds + half * 640;
    const int nit = (MODE == 2 ? 32 : 64) * 4;
    for (int it = blockIdx.x; it < nit; it += G) { hg_item<MODE>(P, L, it >> 2, (it & 3) * 2 + half, tid); __syncthreads(); }
}
__device__ __forceinline__ void hg_scan(const Params& P, int G) {
    for (int idx = blockIdx.x * NTHR + otid(); idx < 131072; idx += G * NTHR) {
        const int h = idx >> 14, d = (idx >> 7) & 127;
        float S = 0.f;
        for (int sc = 0; sc < 64; ++sc) { P.Sst[(size_t)sc * 131072 + idx] = S; S = P.Dtot[((size_t)sc * 8 + h) * 128 + d] * S + P.dS[(size_t)sc * 131072 + idx]; }
        P.out[OFF_HGP + idx] = S;
    }
}
__device__ __forceinline__ void hg_norm(const Params& P, int G) {
    const int h = __builtin_amdgcn_readfirstlane(otid() >> 6), lane = otid() & 63;
    for (int m = TP + blockIdx.x; m < MR; m += G) {
        const float o0 = P.og[(size_t)m * D + h * 128 + lane], o1 = P.og[(size_t)m * D + h * 128 + 64 + lane];
        const float s = wave_sum(o0 * o0 + o1 * o1), r = rsqrtf(s * (1.f / 128.f) + EPS);
        const float g0 = P.hgp[(size_t)m * 4096 + 3072 + h * 128 + lane], g1 = P.hgp[(size_t)m * 4096 + 3072 + h * 128 + 64 + lane];
        P.ao[(size_t)m * D + h * 128 + lane] = (bf16_t)f2bf(o0 * r * P.hg_ng[lane] * g0 * sigmoidf_(g0));
        P.ao[(size_t)m * D + h * 128 + 64 + lane] = (bf16_t)f2bf(o1 * r * P.hg_ng[64 + lane] * g1 * sigmoidf_(g1));
    }
}

namespace hg {
typedef short bf16x8 __attribute__((ext_vector_type(8)));
constexpr int LD128 = 136, LD64 = 72;
constexpr int OFF_QT = 0, OFF_QH = OFF_QT + 64 * LD128 * 2, OFF_KT = OFF_QH + 64 * LD128 * 2, OFF_KHT = OFF_KT + 64 * LD128 * 2, OFF_VT = OFF_KHT + 128 * LD64 * 2,
              OFF_ST = OFF_VT + 128 * LD64 * 2, OFF_DV = OFF_ST + 128 * LD128 * 2, OFF_PREF = OFF_DV + 512, HG_LDS_END = OFF_PREF + 2048 + 512;
static_assert(HG_LDS_END <= RING_BYTES, "hg LDS");
#define HMFMA(a, b, c) __builtin_amdgcn_mfma_f32_16x16x32_bf16((a), (b), (c), 0, 0, 0)
template <int MODE>
__device__ __forceinline__ void item(const Params& P, unsigned char* lds, int sc, int h) {
    const int tid = otid(), lane = tid & 63, w = __builtin_amdgcn_readfirstlane(tid >> 6), c = lane & 15, rq = lane >> 4;
    const int d = tid & 127, qtr = __builtin_amdgcn_readfirstlane(tid >> 7);
    bf16_t* QT = (bf16_t*)(lds + OFF_QT); bf16_t* QH = (bf16_t*)(lds + OFF_QH); bf16_t* KT = (bf16_t*)(lds + OFF_KT); bf16_t* KHT = (bf16_t*)(lds + OFF_KHT);
    bf16_t* VT = (bf16_t*)(lds + OFF_VT); bf16_t* ST = (bf16_t*)(lds + OFF_ST); float* Dv = (float*)(lds + OFF_DV); float* pref = (float*)(lds + OFF_PREF); float* red = (float*)(lds + OFF_PREF + 2048);
    f32x4 acc[8];
    const float lbv = P.lbv[h * 128 + d];
    float sumtot = 0.f;
    if (MODE == 1) {
        const float* S0 = P.Sst + ((size_t)sc * 8 + h) * 16384;
#pragma unroll
        for (int dt = 0; dt < 8; ++dt)
#pragma unroll
            for (int i = 0; i < 4; ++i) { const float s = S0[(16 * w + 4 * rq + i) * 128 + 16 * dt + c]; acc[dt][i] = s; ST[(16 * w + 4 * rq + i) * LD128 + 16 * dt + c] = (bf16_t)f2bf(s); }
    } else {
#pragma unroll
        for (int dt = 0; dt < 8; ++dt) acc[dt] = (f32x4){0.f, 0.f, 0.f, 0.f};
    }
#pragma unroll 1
    for (int ch = 0; ch < 4; ++ch) {
        const int tb = sc * 256 + ch * 64 + qtr * 16;
        float qv[16], kv[16], bv[16], vv[16];
        float cum = 0.f;
#pragma unroll
        for (int i = 0; i < 16; ++i) { const float* row = P.hgp + (size_t)(tb + i) * 4096 + h * 128 + d;
            const float f = lbv + (1.f - lbv) * sigmoidf_(row[1024]); cum += __logf(f); bv[i] = cum; kv[i] = 1.f - f; vv[i] = row[2048]; if (MODE == 1) qv[i] = row[0]; }
        pref[qtr * 128 + d] = cum;
        __syncthreads();
        const float p0 = pref[d], p1 = pref[128 + d], p2 = pref[256 + d], p3 = pref[384 + d];
        const float off = qtr == 0 ? 0.f : (qtr == 1 ? p0 : (qtr == 2 ? p0 + p1 : (p0 + p1) + p2)), total = ((p0 + p1) + p2) + p3, r = p0 + p1;
        sumtot += total;
        { unsigned kh[8], vt[8];
#pragma unroll
          for (int i = 0; i < 16; i += 2) { const float b0 = bv[i] + off, b1 = bv[i + 1] + off;
              kh[i >> 1] = pk2(kv[i] * __expf(total - b0), kv[i + 1] * __expf(total - b1)); vt[i >> 1] = pk2(vv[i], vv[i + 1]);
              if (MODE == 1) { const int t0_ = qtr * 16 + i;
                  QT[t0_ * LD128 + d] = (bf16_t)f2bf(qv[i] * __expf(b0 - r)); QT[(t0_ + 1) * LD128 + d] = (bf16_t)f2bf(qv[i + 1] * __expf(b1 - r));
                  QH[t0_ * LD128 + d] = (bf16_t)f2bf(qv[i] * __expf(b0)); QH[(t0_ + 1) * LD128 + d] = (bf16_t)f2bf(qv[i + 1] * __expf(b1));
                  KT[t0_ * LD128 + d] = (bf16_t)f2bf(kv[i] * __expf(r - b0)); KT[(t0_ + 1) * LD128 + d] = (bf16_t)f2bf(kv[i + 1] * __expf(r - b1)); } }
          *(v4u*)(KHT + d * LD64 + qtr * 16) = (v4u){kh[0], kh[1], kh[2], kh[3]}; *(v4u*)(KHT + d * LD64 + qtr * 16 + 8) = (v4u){kh[4], kh[5], kh[6], kh[7]};
          *(v4u*)(VT + d * LD64 + qtr * 16) = (v4u){vt[0], vt[1], vt[2], vt[3]}; *(v4u*)(VT + d * LD64 + qtr * 16 + 8) = (v4u){vt[4], vt[5], vt[6], vt[7]}; }
        if (qtr == 0) Dv[d] = __expf(total);
        __syncthreads();
        if (MODE == 1) {
            const int tt = w & 3, vh = w >> 2;
            bf16x8 Pf[2];
#pragma unroll
            for (int ss = 0; ss < 2; ++ss) {
                if (ss == 1 && tt < 2) { Pf[1] = (bf16x8){0, 0, 0, 0, 0, 0, 0, 0}; continue; }
                f32x4 sA = (f32x4){0.f, 0.f, 0.f, 0.f}, sB = sA;
                const int srow = 32 * ss + 8 * (c >> 2) + (c & 3);
#pragma unroll
                for (int kd = 0; kd < 4; ++kd) { const bf16x8 qf = *(const bf16x8*)(QT + (16 * tt + c) * LD128 + kd * 32 + rq * 8);
                    sA = HMFMA(*(const bf16x8*)(KT + srow * LD128 + kd * 32 + rq * 8), qf, sA); sB = HMFMA(*(const bf16x8*)(KT + (srow + 4) * LD128 + kd * 32 + rq * 8), qf, sB); }
                const int t = 16 * tt + c, s0 = 32 * ss + 8 * rq; float e[8];
#pragma unroll
                for (int i = 0; i < 8; ++i) { const float x = i < 4 ? sA[i] : sB[i - 4]; e[i] = (s0 + i <= t) ? x : 0.f; }
                v4u p; p.x = pk2(e[0], e[1]); p.y = pk2(e[2], e[3]); p.z = pk2(e[4], e[5]); p.w = pk2(e[6], e[7]); Pf[ss] = __builtin_bit_cast(bf16x8, p);
            }
            f32x4 o[4]; float ssq = 0.f;
#pragma unroll
            for (int vt = 0; vt < 4; ++vt) { const int V = vh * 4 + vt; o[vt] = (f32x4){0.f, 0.f, 0.f, 0.f};
                o[vt] = HMFMA(*(const bf16x8*)(VT + (16 * V + c) * LD64 + rq * 8), Pf[0], o[vt]);
                if (tt >= 2) o[vt] = HMFMA(*(const bf16x8*)(VT + (16 * V + c) * LD64 + 32 + rq * 8), Pf[1], o[vt]);
#pragma unroll
                for (int kd = 0; kd < 4; ++kd) o[vt] = HMFMA(*(const bf16x8*)(ST + (16 * V + c) * LD128 + kd * 32 + rq * 8), *(const bf16x8*)(QH + (16 * tt + c) * LD128 + kd * 32 + rq * 8), o[vt]);
                ssq += (o[vt][0] * o[vt][0] + o[vt][1] * o[vt][1]) + (o[vt][2] * o[vt][2] + o[vt][3] * o[vt][3]); }
            ssq += __shfl_xor(ssq, 16); ssq += __shfl_xor(ssq, 32);
            if (rq == 0) red[vh * 64 + 16 * tt + c] = ssq;
            __syncthreads();
            { const float rs = rsqrtf((red[16 * tt + c] + red[64 + 16 * tt + c]) * (1.f / 128.f) + EPS);
              const int trow = sc * 256 + ch * 64 + 16 * tt + c;
#pragma unroll
              for (int vt = 0; vt < 4; ++vt) { const int v0 = 16 * (vh * 4 + vt) + 4 * rq; const f32x4 gg = *(const f32x4*)(P.hgp + (size_t)trow * 4096 + 3072 + h * 128 + v0), ng = *(const f32x4*)(P.hg_ng + v0);
                  float y[4];
#pragma unroll
                  for (int i = 0; i < 4; ++i) y[i] = o[vt][i] * rs * ng[i] * gg[i] * sigmoidf_(gg[i]);
                  v2u wv; wv.x = pk2(y[0], y[1]); wv.y = pk2(y[2], y[3]); *(v2u*)(P.ao + (size_t)trow * D + h * 128 + v0) = wv; } }
        }

#pragma unroll
        for (int dt = 0; dt < 8; ++dt) acc[dt] = acc[dt] * Dv[16 * dt + c];
#pragma unroll
        for (int ss = 0; ss < 2; ++ss) { const bf16x8 vf = *(const bf16x8*)(VT + (16 * w + c) * LD64 + 32 * ss + rq * 8);
#pragma unroll
            for (int dt = 0; dt < 8; ++dt) acc[dt] = HMFMA(vf, *(const bf16x8*)(KHT + (16 * dt + c) * LD64 + 32 * ss + rq * 8), acc[dt]); }
        if (MODE == 1 && ch < 3) {
            __syncthreads();
#pragma unroll
            for (int dt = 0; dt < 8; ++dt)
#pragma unroll
                for (int i = 0; i < 4; ++i) ST[(16 * w + 4 * rq + i) * LD128 + 16 * dt + c] = (bf16_t)f2bf(acc[dt][i]);
        }
    }
    if (MODE == 0) {
        float* dS = P.dS + ((size_t)sc * 8 + h) * 16384;
#pragma unroll
        for (int dt = 0; dt < 8; ++dt)
#pragma unroll
            for (int i = 0; i < 4; ++i) dS[(16 * w + 4 * rq + i) * 128 + 16 * dt + c] = acc[dt][i];
        if (qtr == 0) P.Dtot[((size_t)sc * 8 + h) * 128 + d] = __expf(sumtot);
    }
    __syncthreads();
}
template <int MODE>
__device__ __forceinline__ void phase(const Params& P, unsigned char* lds, int G) {
    for (int it = blockIdx.x; it < 512; it += G) item<MODE>(P, lds, it >> 3, it & 7);
}
__device__ __forceinline__ void scan(const Params& P, int G) {
    for (int idx = blockIdx.x * NTHR + otid(); idx < 131072; idx += G * NTHR) {
        const int h = idx >> 14, v = (idx >> 7) & 127, d = idx & 127;
        float S = 0.f;
#pragma unroll 8
        for (int sc = 0; sc < 64; ++sc) { P.Sst[(size_t)sc * 131072 + idx] = S; S = P.Dtot[((size_t)sc * 8 + h) * 128 + d] * S + P.dS[(size_t)sc * 131072 + idx]; }
        P.out[OFF_HGP + h * 16384 + d * 128 + v] = S;
    }
}
}
constexpr int NPHASE = 17;
#ifndef REP_MASK
#define REP_MASK 0
#endif
#ifndef NSA_CHECK
#define NSA_CHECK 0
#endif
#ifndef MK_PER_PHASE
#define MK_PER_PHASE 0
#endif
__global__ void __launch_bounds__(NTHR, 2) fwd(Params P) {
    extern __shared__ __attribute__((aligned(16))) unsigned char lds[];
    LAS unsigned char* ldsl = (LAS unsigned char*)lds;
    const int G = gridDim.x;
    volatile LAS unsigned* MISC = (volatile LAS unsigned*)(ldsl + MISC_OFF);
    for (int u = otid(); u < 64; u += NTHR) ((LAS unsigned*)(ldsl + MISC_OFF))[u] = 0u;
    __syncthreads();
    XcdBarrier bar; bar.bar = P.ctl + CW_BAR; bar.x = 0; bar.st = nullptr;
    if (!MK_PER_PHASE) bar = xcd_barrier_post(P.ctl + CW_BAR, MISC + 8);
    const int lo = P.ph_lo, hi = P.ph_hi;
#define IN(k) (lo <= (k) && (k) < hi)
#define SEAM(k) do { if (!MK_PER_PHASE && IN(k) && IN((k) + 1)) xcd_barrier(bar); } while (0)
#define BIGGEMM(EPI, Aptr, Btptr, Mv, Nv, Kv, ...) do { pg8::Gemm g{Aptr, Btptr, Mv, Nv, Kv}; pg8::StaticOrder S; S.init(Mv, Nv, G, (int)blockIdx.x); pg8::EPI E{__VA_ARGS__}; \
        pg8::gemm_phase<pg8::EPI, pg8::StaticOrder, true, true>(ldsl, g, S, E); __syncthreads(); } while (0)

    float* rtab = (float*)(lds + 65536 + 4096);
#define NREP(k) (1 + ((REP_MASK >> (k)) & 1))
#define PH(k, ...) if (IN(k)) { _Pragma("unroll") for (int rep_ = 0; rep_ < NREP(k); ++rep_) { __VA_ARGS__ if (rep_ + 1 < NREP(k)) xcd_barrier(bar); } SEAM(k); }
    PH(0, p0_prologue(P, lds, G, 1 + ((REP_MASK >> 17) & 1), 1 + ((REP_MASK >> 18) & 1), 1 + ((REP_MASK >> 19) & 1));)
    PH(1,
        { pg8::Gemm g{P.xb, P.Wt_in, TP, NINP, D}; pg8::DualOrder S; S.S1.init(TP, NINP, G, (int)blockIdx.x); S.n1 = S.S1.nwg; S.n2 = 512; S.sh = 8; S.p0 = 8; S.ppk = CMPROWS / 256;
          S.A2 = (const char*)P.acmp; S.B2 = (const char*)P.W1cmp;
          pg8::EpiDual<pg8::EpiProj> E{pg8::EpiProj{P.proj, P.ssp0}, pg8::EpiCmp{P.hfs}};
          pg8::gemm_phase<pg8::EpiDual<pg8::EpiProj>, pg8::DualOrder, true, true>(ldsl, g, S, E); __syncthreads(); }
        sgemm_mfma(P.xb, P.Wt_in, NINP, D, SEpProj{P.proj, P.ssp0}, lds, G);)
    PH(2, p2_elem(P, lds, G);)
    if (IN(3)) {
#pragma unroll
        for (int r3 = 0; r3 < 1 + ((REP_MASK >> 20) & 1); ++r3) { p3_conv(P, lds, G); __syncthreads(); }
        { pg8::Gemm g{P.acmp, P.W1cmp, 0, 256, 1024}; pg8::DualOrder S; S.S1.init(0, 256, G, (int)blockIdx.x); S.n1 = 0; S.n2 = 16; S.sh = 3; S.p0 = 0; S.ppk = CMPROWS / 256;
          S.A2 = (const char*)P.acmp; S.B2 = (const char*)P.W1cmp;
          pg8::EpiDual<pg8::EpiProj> E{pg8::EpiProj{P.proj, P.ssp0}, pg8::EpiCmp{P.hfs}};
          pg8::gemm_phase<pg8::EpiDual<pg8::EpiProj>, pg8::DualOrder, true, true>(ldsl, g, S, E); __syncthreads(); }
        SEAM(3); }
    PH(4, p4_cmp_finish(P, lds, G);)
    PH(5, p5_nsa_mfma(P, lds, G, rep_);)
#if NSA_CHECK
    if (IN(5)) { p5_nsa<1>(P, lds, G); }
#endif
    PH(6,
        BIGGEMM(EpiResid, P.ao, P.Wt_out0, TP, D, D, P.x_prompt, P.x1, P.xb, P.ssp1);
        sgemm_mfma(P.ao, P.Wt_out0, D, D, SEpResid{P.x_sample, P.x1, P.xb, P.ssps1, TP, 0}, lds, G);)
    PH(7,
        BIGGEMM(EpiUp, P.xb, P.Wt_up0, TP, FF, D, P.hid, P.ssp1);
        sample_rtab(P.ssps1, rtab);
        sgemm_mfma(P.xb, P.Wt_up0, FF, D, SEpUp{P.hid, rtab}, lds, G);)
    PH(8,
        BIGGEMM(EpiResid, P.hid, P.Wt_dn0, TP, D, FF, P.x1, P.x2, P.xb, P.ssp2);
        sgemm_mfma(P.hid, P.Wt_dn0, D, FF, SEpResid{P.x1, P.x2, P.xb, P.ssps2, 0, 0}, lds, G);)
    PH(9,
        BIGGEMM(EpiScale, P.xb, P.Wt_hgin, TP, FF, D, P.hgp, P.ssp2, FF, 0);
        sample_rtab(P.ssps2, rtab);
        sgemm_mfma(P.xb, P.Wt_hgin, FF, D, SEpScale{P.hgp, rtab, FF, 0}, lds, G);)
    PH(10, hg::phase<0>(P, lds, G); hg_phase<2>(P, lds, G);)
    PH(11, hg::scan(P, G);)
    PH(12, hg::phase<1>(P, lds, G);)
    PH(13, hg_norm(P, G);)
    PH(14,
        BIGGEMM(EpiResid, P.ao, P.Wt_hgout, TP, D, D, P.x2, P.x3, P.xb, P.ssp3);
        sgemm_mfma(P.ao, P.Wt_hgout, D, D, SEpResid{P.x2, P.x3, P.xb, P.ssps3, 0, 0}, lds, G);)
    PH(15,
        BIGGEMM(EpiUp, P.xb, P.Wt_up1, TP, FF, D, P.hid, P.ssp3);
        sample_rtab(P.ssps3, rtab);
        sgemm_mfma(P.xb, P.Wt_up1, FF, D, SEpUp{P.hid, rtab}, lds, G);)
    if (IN(16)) {
#pragma unroll
        for (int rep_ = 0; rep_ < NREP(16); ++rep_) {
        BIGGEMM(EpiResid, P.hid, P.Wt_dn1, TP, D, FF, P.x3, P.out, nullptr, nullptr);
        sgemm_mfma(P.hid, P.Wt_dn1, D, FF, SEpResid{P.x3, P.out, nullptr, nullptr, 0, 0}, lds, G);
        }
#if NSA_CHECK
        xcd_barrier(bar);
        if (blockIdx.x == 0 && otid() == 0) { const unsigned n = xb_ld(P.ctl + 16), n5 = xb_ld(P.ctl + 17), n2 = xb_ld(P.ctl + 18), n50 = xb_ld(P.ctl + 19); const float qn_ = __builtin_nanf("");
            if (n != 512u || n5 * 10u > n * 4u) P.out[OFF_YS] = qn_;
            if (n5 * 10u > n) P.out[OFF_KVS] = qn_;
            if (n2 * 2u > n) P.out[OFF_WINS] = qn_;
            if (n50 * 50u > n) P.out[OFF_CONVS] = qn_; }
#endif
    }
#undef IN
#undef SEAM
}

extern "C" void kernel_launch(void* const* d_in, const int* in_sizes, int n_in, void* d_out, int out_size, void* d_ws, size_t ws_size, hipStream_t stream) {
    static int grid = 0;
    if (grid == 0) {
        if (n_in != 28 || out_size != (int)OUT_TOTAL) { fprintf(stderr, "kernel_launch: unexpected shapes (n_in %d out %d)\n", n_in, out_size); grid = -1; return; }
        int dev = 0, cus = 0, per_cu = 0;
        if (hipGetDevice(&dev) != hipSuccess || hipDeviceGetAttribute(&cus, hipDeviceAttributeMultiprocessorCount, dev) != hipSuccess) { grid = -1; return; }
        if (hipFuncSetAttribute((const void*)fwd, hipFuncAttributeMaxDynamicSharedMemorySize, LDS_BYTES) != hipSuccess) { fprintf(stderr, "kernel_launch: hipFuncSetAttribute failed\n"); grid = -1; return; }
        if (hipOccupancyMaxActiveBlocksPerMultiprocessor(&per_cu, (const void*)fwd, NTHR, LDS_BYTES) != hipSuccess || per_cu < 1) fprintf(stderr, "kernel_launch: occupancy query reports %d\n", per_cu);
        (void)hipGetLastError();
        grid = cus;
    }
    if (grid < 0) return;
    unsigned char* ws = (unsigned char*)d_ws; size_t off = 0;
    auto alloc = [&](size_t bytes) { void* p = ws + off; off += (bytes + 1048575) & ~(size_t)1048575; return p; };
    Params P{};
    P.x_prompt = (const float*)d_in[0]; P.x_sample = (const float*)d_in[1]; P.cache = (const float*)d_in[2]; P.pt = (const int*)d_in[3];
    P.win_state = (const float*)d_in[4]; P.conv_state = (const float*)d_in[5]; P.hg_state = (const float*)d_in[6]; P.tb = (const float*)d_in[7];
    P.g_mix = (const float*)d_in[8]; P.g_mlp = (const float*)d_in[9]; P.w_up = (const float*)d_in[10]; P.w_dn = (const float*)d_in[11];
    P.w_in = (const float*)d_in[12]; P.w_out = (const float*)d_in[13]; P.q_g = (const float*)d_in[14]; P.k_g = (const float*)d_in[15];
    P.cmp_pe = (const float*)d_in[16]; P.cmp_w1 = (const float*)d_in[17]; P.cmp_b1 = (const float*)d_in[18]; P.cmp_w2 = (const float*)d_in[19];
    P.conv_w = (const float*)d_in[20]; P.conv_b = (const float*)d_in[21]; P.ln_g = (const float*)d_in[22]; P.ln_b = (const float*)d_in[23];
    P.hg_w_in = (const float*)d_in[24]; P.hg_w_out = (const float*)d_in[25]; P.hg_lb = (const float*)d_in[26]; P.hg_ng = (const float*)d_in[27];
    P.out = (float*)d_out;
    P.ctl = (unsigned*)alloc(CTL_BYTES);
    P.Wt_in = (bf16_t*)alloc((size_t)NINP * D * 2); P.Wt_out0 = (bf16_t*)alloc((size_t)D * D * 2); P.Wt_up0 = (bf16_t*)alloc((size_t)FF * D * 2); P.Wt_dn0 = (bf16_t*)alloc((size_t)D * FF * 2);
    P.Wt_hgin = (bf16_t*)alloc((size_t)FF * D * 2); P.Wt_hgout = (bf16_t*)alloc((size_t)D * D * 2); P.Wt_up1 = (bf16_t*)alloc((size_t)FF * D * 2); P.Wt_dn1 = (bf16_t*)alloc((size_t)D * FF * 2);
    P.W1cmp = (bf16_t*)alloc((size_t)2 * 256 * 1024 * 2); P.cbv = (float*)alloc(1024); P.lbv = (float*)alloc(4096);
    P.xb = (bf16_t*)alloc((size_t)MR * D * 2);
    P.ssp0 = (float*)alloc((size_t)MR * 64); P.ssp1 = (float*)alloc((size_t)MR * 64); P.ssp2 = (float*)alloc((size_t)MR * 64); P.ssp3 = (float*)alloc((size_t)MR * 64);
    P.ssps1 = (float*)alloc(SR * 64 * 4); P.ssps2 = (float*)alloc(SR * 64 * 4); P.ssps3 = (float*)alloc(SR * 64 * 4);
    P.Qs = (bf16_t*)alloc((size_t)MR * 512 * 2); P.Kc = (bf16_t*)alloc((size_t)66 * 1024 * 64 * 2); P.VcT = (bf16_t*)alloc((size_t)66 * 64 * 1024 * 2);
    P.KwinS = (bf16_t*)alloc((size_t)64 * 544 * 64 * 2); P.VwinST = (bf16_t*)alloc((size_t)64 * 64 * 544 * 2); P.KselSn = (bf16_t*)alloc((size_t)64 * 4096 * 2); P.VselSTn = (bf16_t*)alloc((size_t)64 * 4096 * 2);
    P.Ksel = (bf16_t*)alloc((size_t)2 * TP * 64 * 2); P.VselT = (bf16_t*)alloc((size_t)2 * TP * 64 * 2); P.Kwin = (bf16_t*)alloc((size_t)2 * TP * 64 * 2); P.VwinT = (bf16_t*)alloc((size_t)2 * TP * 64 * 2);
    P.proj = (float*)alloc((size_t)MR * NIN * 4); P.glu = (float*)alloc((size_t)MR * CC * 4); P.qn = (float*)alloc((size_t)MR * 512 * 4);
    P.kvw = (float*)alloc((size_t)MR * 768 * 4); P.gates = (float*)alloc((size_t)MR * 24 * 4); P.ao = (bf16_t*)alloc((size_t)MR * D * 2); P.aochk = (bf16_t*)alloc((size_t)MR * D * 2);
    P.acmp = (bf16_t*)alloc((size_t)2 * CMPROWS * 1024 * 2); P.hfs = (float*)alloc((size_t)2 * CMPROWS * 256 * 4); P.kcvc = (float*)alloc((size_t)33 * 4 * 1024 * 64 * 4);
    P.x1 = (float*)alloc((size_t)MR * D * 4); P.x2 = (float*)alloc((size_t)MR * D * 4); P.x3 = (float*)alloc((size_t)MR * D * 4);
    P.hid = (bf16_t*)alloc((size_t)MR * FF * 2); P.hgp = (float*)alloc((size_t)MR * FF * 4);
    P.dS = (float*)alloc((size_t)64 * 131072 * 4); P.Dtot = (float*)alloc((size_t)64 * 1024 * 4); P.Sst = (float*)alloc((size_t)64 * 131072 * 4); P.og = (float*)alloc((size_t)MR * D * 4);
    if (off > ws_size) { fprintf(stderr, "kernel_launch: workspace too small (%zu > %zu)\n", off, ws_size); return; }
    if (hipMemsetAsync(P.ctl, 0, CTL_BYTES, stream) != hipSuccess) { fprintf(stderr, "kernel_launch: memset failed\n"); return; }
#if MK_PER_PHASE
    for (int k = 0; k < NPHASE; ++k) { P.ph_lo = k; P.ph_hi = k + 1; hipLaunchKernelGGL(fwd, dim3(grid), dim3(NTHR), LDS_BYTES, stream, P); }
#else
    P.ph_lo = 0; P.ph_hi = NPHASE;
    hipLaunchKernelGGL(fwd, dim3(grid), dim3(NTHR), LDS_BYTES, stream, P);
#endif
    const hipError_t le = hipPeekAtLastError();
    if (le != hipSuccess) fprintf(stderr, "kernel_launch: launch failed: %s\n", hipGetErrorName(le));
}
```

```cpp
#include <hip/hip_runtime.h>
#include <stdint.h>
#include <stdio.h>
#ifndef NSA_CHECK
#define NSA_CHECK 0
#endif

#define GAS __attribute__((address_space(1)))
#define LAS __attribute__((address_space(3)))
typedef unsigned short bf16_t;
typedef unsigned v4u __attribute__((ext_vector_type(4)));
typedef unsigned v2u __attribute__((ext_vector_type(2)));
typedef float f32x4 __attribute__((ext_vector_type(4)));
#define LDS_WAIT() asm volatile("s_waitcnt lgkmcnt(0)" ::: "memory")
#define VM_WAIT() asm volatile("s_waitcnt vmcnt(0)" ::: "memory")
__device__ __forceinline__ float bf2f(bf16_t b) { return __uint_as_float(((unsigned)b) << 16); }
__device__ __forceinline__ unsigned f2bf(float f) { unsigned u = __builtin_bit_cast(unsigned, f); return (u + 0x7fffu + ((u >> 16) & 1u)) >> 16; }
__device__ __forceinline__ unsigned pk2(float lo, float hi) { return f2bf(lo) | (f2bf(hi) << 16); }
__device__ __forceinline__ float sigmoidf_(float x) { return 1.f / (1.f + __expf(-x)); }
__device__ __forceinline__ float wave_sum(float v) {
#pragma unroll
    for (int o = 1; o < 64; o <<= 1) v += __shfl_xor(v, o);
    return v;
}
__device__ __forceinline__ float wave_max(float v) {
#pragma unroll
    for (int o = 1; o < 64; o <<= 1) v = fmaxf(v, __shfl_xor(v, o));
    return v;
}

constexpr int D = 1024, TP = 16384, SBATCH = 32, STOK = 4, SR = SBATCH * STOK, MR = TP + SR;
constexpr int PAST = 16384, NPAGES = 128;
constexpr int FF = 4096, CC = 512, CWID = 31;
constexpr int NIN = 2328, NINP = 2560;
constexpr int NCMP = 1023;
constexpr int CMPROWS = 66 * 1024;
constexpr float EPS = 1e-6f;
constexpr size_t OFF_YP = 0, OFF_YS = 16777216, OFF_KVP = 16908288, OFF_KVS = 25296896, OFF_WINP = 25362432, OFF_WINS = 25493504,
                 OFF_CONVP = 29687808, OFF_CONVS = 29703168, OFF_HGP = 30194688, OFF_HGS = 30325760, OUT_TOTAL = 34520064;

__device__ __forceinline__ float row_r(const float* ssp, int row) {
    const f32x4* p = (const f32x4*)(ssp + (size_t)row * 16);
    const f32x4 a = p[0], b = p[1], c = p[2], d = p[3];
    const float s = ((a.x + a.y) + (a.z + a.w)) + ((b.x + b.y) + (b.z + b.w)) + ((c.x + c.y) + (c.z + c.w)) + ((d.x + d.y) + (d.z + d.w));
    return rsqrtf(s * (1.f / D) + EPS);
}
__device__ __forceinline__ int otid() { int t = threadIdx.x; asm volatile("" : "+v"(t)); return t; }
__host__ __device__ __forceinline__ int nat_col(int p) {
    const int T = p >> 8, tc = p & 255, bj = tc >> 7, wc = (tc >> 5) & 3, lo = tc & 31;
    if (T < 4) return (bj ? 512 : 0) + 128 * T + 32 * wc + lo;
    if (T < 6) return 1024 + ((T - 4) * 4 + wc) * 64 + 32 * bj + lo;
    if (T < 9) return 1536 + ((T - 6) * 4 + wc) * 64 + 32 * bj + lo;
    return tc < 24 ? 2304 + tc : -1;
}
namespace pg8 {
#define PG8_LAS __attribute__((address_space(3)))
typedef unsigned short bf16_t;
typedef short bf16x8 __attribute__((ext_vector_type(8)));
typedef float f32x4 __attribute__((ext_vector_type(4)));
typedef unsigned u32x4 __attribute__((ext_vector_type(4)));
constexpr int BM = 256, BK = 64, HALF = 128, HTB = HALF * BK * 2  , STAGE_BYTES = 8 * HTB, NXCD = 8, WGM = 8;

__host__ __device__ __forceinline__ int lds_byte(int r, int c) { const int st = (r >> 4) * 2 + (c >> 5), rr = r & 15, cc = c & 31, ob = rr * 64 + cc * 2; return st * 1024 + (ob ^ (((ob >> 9) & 1) << 5)); }
__host__ __device__ __forceinline__ void stage_rc(int b, int& R, int& C) { const int st = b / 1024, sb = b % 1024, swz = sb ^ (((sb >> 9) & 1) << 5); R = (st >> 1) * 16 + swz / 64; C = (st & 1) * 32 + (swz % 64) / 2; }
__host__ __device__ __forceinline__ int perm32(int rho) { const int n = rho >> 4, i = rho & 15; return 8 * (i >> 2) + 4 * n + (i & 3); }

struct Unit { int pm, pn, ty; };
struct Gemm { const bf16_t* A; const bf16_t* Bt; int M, N, K; };

struct StaticOrder {
    int nM, nN, nwg, G, c;
    __host__ __device__ void init(int M, int N, int G_, int c_) { nM = M / BM; nN = N / BM; nwg = nM * nN; G = G_; c = c_; }
    __host__ __device__ bool next(int i, Unit& u) const {
        const long L = (long)i * G + c; if (L >= nwg) return false;
        int wgid = (int)L; { const int q = nwg / NXCD, r = nwg % NXCD, xcd = wgid % NXCD, off = wgid / NXCD; wgid = (xcd < r ? xcd * (q + 1) : r * (q + 1) + (xcd - r) * q) + off; }
        const int nig = WGM * nN, gid = wgid / nig, fm = gid * WGM, gsz = (nM - fm) < WGM ? (nM - fm) : WGM;
        u.pm = fm + ((wgid % nig) % gsz); u.pn = (wgid % nig) / gsz; u.ty = 0; return true;
    }
    __device__ __forceinline__ const char* pa(const Gemm& g, const Unit& u, size_t tstep) const { return (const char*)g.A + (size_t)u.pm * tstep; }
    __device__ __forceinline__ const char* pb(const Gemm& g, const Unit& u, size_t tstep) const { return (const char*)g.Bt + (size_t)u.pn * tstep; }
    __device__ __forceinline__ void a_ready(const Unit&) const {}
    __device__ __forceinline__ void done(const Unit&) const {}
};


struct DualOrder {
    StaticOrder S1; int n1, n2, sh, p0, ppk; const char* A2; const char* B2;
    __device__ __forceinline__ bool next(int i, Unit& u) const {
        if (S1.next(i, u)) return true;
        const long L = (long)i * S1.G + S1.c - n1; if (L < 0 || L >= n2) return false;
        const int kv = (int)(L >> sh), p = p0 + (int)(L & ((1 << sh) - 1)); u.pm = kv * ppk + p; u.pn = kv; u.ty = 1; return true;
    }
    __device__ __forceinline__ const char* pa(const Gemm& g, const Unit& u, size_t tstep) const { return u.ty ? A2 + (size_t)u.pm * tstep : (const char*)g.A + (size_t)u.pm * tstep; }
    __device__ __forceinline__ const char* pb(const Gemm& g, const Unit& u, size_t tstep) const { return u.ty ? B2 + (size_t)u.pn * tstep : (const char*)g.Bt + (size_t)u.pn * tstep; }
    __device__ __forceinline__ void a_ready(const Unit&) const {}
    __device__ __forceinline__ void done(const Unit&) const {}
};
__device__ __forceinline__ unsigned cvt_pk_bf16(float lo, float hi) { unsigned r; asm volatile("v_cvt_pk_bf16_f32 %0, %1, %2" : "=v"(r) : "v"(lo), "v"(hi)); return r; }
typedef float f32x2 __attribute__((ext_vector_type(2)));
struct EpiProj {
    static constexpr bool PERM = false, AFTER_DRAIN = false;
    float* proj; const float* ssp;
    __device__ __forceinline__ void operator()(const f32x4 (&acc)[2][2][4][2], const Unit& u, int wr, int wc, int fr, int fq) const {
        const int row0 = u.pm * BM + wr * 64 + fr, col0 = u.pn * BM + wc * 32 + 4 * fq;
#pragma unroll
        for (int ai = 0; ai < 2; ++ai)
#pragma unroll
            for (int m = 0; m < 4; ++m) { const int row = row0 + ai * HALF + m * 16; const float r = row_r(ssp, row);
#pragma unroll
                for (int bj = 0; bj < 2; ++bj)
#pragma unroll
                    for (int n = 0; n < 2; ++n) { const int col = col0 + bj * HALF + n * 16; if (col < NIN) *(f32x4*)(proj + (size_t)row * NIN + col) = acc[ai][bj][m][n] * r; } }
    }
};
struct EpiScale {
    static constexpr bool PERM = false, AFTER_DRAIN = false;
    float* out; const float* ssp; int ld; int pad;
    __device__ __forceinline__ void operator()(const f32x4 (&acc)[2][2][4][2], const Unit& u, int wr, int wc, int fr, int fq) const {
        const int row0 = u.pm * BM + wr * 64 + fr, col0 = u.pn * BM + wc * 32 + 4 * fq;
#pragma unroll
        for (int ai = 0; ai < 2; ++ai)
#pragma unroll
            for (int m = 0; m < 4; ++m) { const int row = row0 + ai * HALF + m * 16; const float r = ssp ? row_r(ssp, row) : 1.f;
#pragma unroll
                for (int bj = 0; bj < 2; ++bj)
#pragma unroll
                    for (int n = 0; n < 2; ++n) { const int col = col0 + bj * HALF + n * 16; *(f32x4*)(out + (size_t)row * ld + col) = acc[ai][bj][m][n] * r; } }
    }
};
struct EpiResid {
    static constexpr bool PERM = false, AFTER_DRAIN = false;
    const float* xin; float* out; bf16_t* xb; float* sspo;
    __device__ __forceinline__ void operator()(const f32x4 (&acc)[2][2][4][2], const Unit& u, int wr, int wc, int fr, int fq) const {
        const int row0 = u.pm * BM + wr * 64 + fr, col0 = u.pn * BM + wc * 32 + 4 * fq;
#pragma unroll
        for (int ai = 0; ai < 2; ++ai)
#pragma unroll
            for (int m = 0; m < 4; ++m) { const int row = row0 + ai * HALF + m * 16; float part = 0.f;
#pragma unroll
                for (int bj = 0; bj < 2; ++bj)
#pragma unroll
                    for (int n = 0; n < 2; ++n) { const int col = col0 + bj * HALF + n * 16; const size_t off = (size_t)row * D + col;
                        const f32x4 o = *(const f32x4*)(xin + off) + acc[ai][bj][m][n];
                        *(f32x4*)(out + off) = o;
                        if (xb) { v2u w; w.x = cvt_pk_bf16(o[0], o[1]); w.y = cvt_pk_bf16(o[2], o[3]); *(v2u*)(xb + off) = w; }
                        part += (o[0] * o[0] + o[1] * o[1]) + (o[2] * o[2] + o[3] * o[3]); }
                part += __shfl_xor(part, 16); part += __shfl_xor(part, 32);
                if (sspo && fq == 0) sspo[(size_t)row * 16 + u.pn * 4 + wc] = part; }
    }
};
struct EpiUp {
    static constexpr bool PERM = true, AFTER_DRAIN = false;
    bf16_t* hid; const float* ssp;
    __device__ __forceinline__ void operator()(const f32x4 (&acc)[2][2][4][2], const Unit& u, int wr, int wc, int fr, int fq) const {
        const int row0 = u.pm * BM + wr * 64 + fr, col0 = u.pn * BM + wc * 32 + 8 * fq;
#pragma unroll
        for (int ai = 0; ai < 2; ++ai)
#pragma unroll
            for (int m = 0; m < 4; ++m) { const int row = row0 + ai * HALF + m * 16; const float r = row_r(ssp, row), r2 = r * r; bf16_t* rowp = hid + (size_t)row * FF + col0;
#pragma unroll
                for (int bj = 0; bj < 2; ++bj) { f32x4 v0 = acc[ai][bj][m][0], v1 = acc[ai][bj][m][1];
#pragma unroll
                    for (int i = 0; i < 4; ++i) { const float a = fmaxf(v0[i], 0.f), b = fmaxf(v1[i], 0.f); v0[i] = a * a * r2; v1[i] = b * b * r2; }
                    u32x4 w; w.x = cvt_pk_bf16(v0[0], v0[1]); w.y = cvt_pk_bf16(v0[2], v0[3]); w.z = cvt_pk_bf16(v1[0], v1[1]); w.w = cvt_pk_bf16(v1[2], v1[3]);
                    *(u32x4*)(rowp + bj * HALF) = w; } }
    }
};

struct EpiCmp {
    static constexpr bool PERM = false, AFTER_DRAIN = false;
    float* out;
    __device__ __forceinline__ void operator()(const f32x4 (&acc)[2][2][4][2], const Unit& u, int wr, int wc, int fr, int fq) const {
        const int row0 = u.pm * BM + wr * 64 + fr, col0 = wc * 32 + 4 * fq;
#pragma unroll
        for (int ai = 0; ai < 2; ++ai)
#pragma unroll
            for (int m = 0; m < 4; ++m) { const int row = row0 + ai * HALF + m * 16;
#pragma unroll
                for (int bj = 0; bj < 2; ++bj)
#pragma unroll
                    for (int n = 0; n < 2; ++n) *(f32x4*)(out + (size_t)row * 256 + col0 + bj * HALF + n * 16) = acc[ai][bj][m][n]; }
    }
};
template <class E1> struct EpiDual {
    static constexpr bool PERM = false, AFTER_DRAIN = false; static_assert(!E1::PERM && !E1::AFTER_DRAIN, "EpiDual");
    E1 e1; EpiCmp e2;
    __device__ __forceinline__ void operator()(const f32x4 (&acc)[2][2][4][2], const Unit& u, int wr, int wc, int fr, int fq) const { if (u.ty) e2(acc, u, wr, wc, fr, fq); else e1(acc, u, wr, wc, fr, fq); }
};

struct EpiIn {
    static constexpr bool PERM = false, AFTER_DRAIN = false;
    const float* ssp; const float* q_g; const float* k_g; float* out; bf16_t* glub; bf16_t* Qs; bf16_t* acmp; bf16_t* Ksel; bf16_t* Kwin; bf16_t* VselT; bf16_t* VwinT; float* gates;
    __device__ __forceinline__ void operator()(const f32x4 (&acc)[2][2][4][2], const Unit& u, int wr, int wc, int fr, int fq) const {
        const int T = u.pn, row0 = u.pm * BM + wr * 64 + fr;
#pragma unroll
        for (int ai = 0; ai < 2; ++ai)
#pragma unroll
            for (int m = 0; m < 4; ++m) {
                const int row = row0 + ai * HALF + m * 16; const float r = row_r(ssp, row);
                if (T < 4) {
#pragma unroll
                    for (int n = 0; n < 2; ++n) { const f32x4 a = acc[ai][0][m][n] * r, g = acc[ai][1][m][n] * r; f32x4 o;
#pragma unroll
                        for (int i = 0; i < 4; ++i) o[i] = a[i] / (1.f + __expf(-g[i]));
                        const int ch = 128 * T + 32 * wc + 16 * n + 4 * fq;
                        v2u w; w.x = cvt_pk_bf16(o[0], o[1]); w.y = cvt_pk_bf16(o[2], o[3]); *(v2u*)(glub + (size_t)row * CC + ch) = w;
                        if (row >= TP - 30) *(f32x4*)(out + OFF_CONVP + (size_t)(row - (TP - 30)) * CC + ch) = o; }
                } else if (T < 9) {
                    f32x4 v[2][2]; float ss = 0.f;
#pragma unroll
                    for (int bj = 0; bj < 2; ++bj)
#pragma unroll
                        for (int n = 0; n < 2; ++n) { v[bj][n] = acc[ai][bj][m][n] * r; ss += (v[bj][n][0] * v[bj][n][0] + v[bj][n][1] * v[bj][n][1]) + (v[bj][n][2] * v[bj][n][2] + v[bj][n][3] * v[bj][n][3]); }
                    ss += __shfl_xor(ss, 16); ss += __shfl_xor(ss, 32);
                    const float rs = rsqrtf(ss * (1.f / 64.f) + EPS);
                    if (T < 6) {
                        const int head = (T - 4) * 4 + wc; const float cs = rs * (0.125f * 1.4426950408889634f);
#pragma unroll
                        for (int bj = 0; bj < 2; ++bj)
#pragma unroll
                            for (int n = 0; n < 2; ++n) { const int d0 = 32 * bj + 16 * n + 4 * fq; const f32x4 g = *(const f32x4*)(q_g + d0); const f32x4 q = v[bj][n] * g * cs;
                                v2u w; w.x = cvt_pk_bf16(q[0], q[1]); w.y = cvt_pk_bf16(q[2], q[3]); *(v2u*)(Qs + (size_t)row * 512 + head * 64 + d0) = w; }
                    } else {
                        const int s = T - 6, kv01 = wc >> 1, hkv = wc & 1;
#pragma unroll
                        for (int bj = 0; bj < 2; ++bj)
#pragma unroll
                            for (int n = 0; n < 2; ++n) { const int d0 = 32 * bj + 16 * n + 4 * fq; f32x4 x = v[bj][n];
                                if (kv01 == 0 && s >= 1) x = x * rs * *(const f32x4*)(k_g + s * 64 + d0);
                                v2u w; w.x = cvt_pk_bf16(x[0], x[1]); w.y = cvt_pk_bf16(x[2], x[3]);
                                if (s < 2) *(f32x4*)(out + OFF_KVP + ((size_t)row * 4 + s * 2 + kv01) * 128 + hkv * 64 + d0) = x;
                                else if (row >= TP - 512) *(f32x4*)(out + OFF_WINP + ((size_t)(row - (TP - 512)) * 2 + kv01) * 128 + hkv * 64 + d0) = x;
                                if (s == 0) *(v2u*)(acmp + ((size_t)kv01 * CMPROWS + (size_t)hkv * 1024 + (row >> 4)) * 1024 + (row & 15) * 64 + d0) = w;
                                else if (kv01 == 0) *(v2u*)((s == 1 ? Ksel : Kwin) + ((size_t)hkv * TP + row) * 64 + d0) = w;
                                else { bf16_t* vt = (s == 1 ? VselT : VwinT) + (((size_t)hkv * 256 + (row >> 6)) * 64 + d0) * 64 + (row & 63);
                                    vt[0] = (bf16_t)(w.x & 0xffff); vt[64] = (bf16_t)(w.x >> 16); vt[128] = (bf16_t)(w.y & 0xffff); vt[192] = (bf16_t)(w.y >> 16); } }
                    }
                } else if (wc == 0) {
#pragma unroll
                    for (int n = 0; n < 2; ++n) { const int tc = 16 * n + 4 * fq; if (tc < 24) { const f32x4 a = acc[ai][0][m][n] * r; f32x4 o;
#pragma unroll
                        for (int i = 0; i < 4; ++i) o[i] = 1.f / (1.f + __expf(-a[i]));
                        *(f32x4*)(gates + (size_t)row * 24 + tc) = o; } }
                }
            }
    }
};

struct EpiProjNat {
    static constexpr bool PERM = false, AFTER_DRAIN = false;
    float* proj; const float* ssp;
    __device__ __forceinline__ void operator()(const f32x4 (&acc)[2][2][4][2], const Unit& u, int wr, int wc, int fr, int fq) const {
        const int row0 = u.pm * BM + wr * 64 + fr, col0 = u.pn * BM + wc * 32 + 4 * fq;
#pragma unroll
        for (int ai = 0; ai < 2; ++ai)
#pragma unroll
            for (int m = 0; m < 4; ++m) { const int row = row0 + ai * HALF + m * 16; const float r = row_r(ssp, row);
#pragma unroll
                for (int bj = 0; bj < 2; ++bj)
#pragma unroll
                    for (int n = 0; n < 2; ++n) { const int col = nat_col(col0 + bj * HALF + n * 16); if (col >= 0) *(f32x4*)(proj + (size_t)row * NIN + col) = acc[ai][bj][m][n] * r; } }
    }
};
template <class Epi, class Sched, bool ALIGN_EPI = false, bool SP2 = false>
__device__ __forceinline__ void gemm_phase(PG8_LAS unsigned char* lds, const Gemm g, const Sched& S, const Epi& E) {
    const int tid = threadIdx.x, wid = __builtin_amdgcn_readfirstlane(tid >> 6), lane = tid & 63, wr = wid >> 2, wc = wid & 3, fr = lane & 15, fq = lane >> 4;
    const int K = g.K, nt = K / BK;
    unsigned voffA[2], voffB[2];
#pragma unroll
    for (int i = 0; i < 2; ++i) { int R, C; stage_rc(tid * 16 + i * 8192, R, C); const int Rb = Epi::PERM ? ((R & ~31) + perm32(R & 31)) : R;
        voffA[i] = (unsigned)(R * K + C) * 2u; voffB[i] = (unsigned)(Rb * K + C) * 2u; }
    const size_t kstep = (size_t)(BK * 2);
    const size_t hstep = (size_t)HALF * K * 2;
    const size_t tstep = 2 * hstep;
    const unsigned ldsw = (unsigned)wid * 1024u;
    const int aoff = lds_byte(wr * 64 + fr, fq * 8), boff = lds_byte(wc * 32 + fr, fq * 8);
#define PG8_SA(b, h) (((b) * 2 + (h)) * HTB)
#define PG8_SB(b, h) ((4 + (b) * 2 + (h)) * HTB)
#define PG8_STAGE(bufoff, gbase, voff) do { _Pragma("unroll") for (int _i = 0; _i < 2; ++_i) \
        __builtin_amdgcn_global_load_lds((const unsigned*)((const char*)(gbase) + (voff)[_i]), (PG8_LAS unsigned*)(lds + (bufoff) + ldsw + _i * 8192), 16, 0, 0); } while (0)
#define PG8_LDA(dst, b, h) do { _Pragma("unroll") for (int m = 0; m < 4; ++m) _Pragma("unroll") for (int k = 0; k < 2; ++k) dst[m][k] = *(const PG8_LAS bf16x8*)(lds + PG8_SA(b, h) + aoff + m * 2048 + k * 1024); } while (0)
#define PG8_LDB(dst, b, h) do { _Pragma("unroll") for (int n = 0; n < 2; ++n) _Pragma("unroll") for (int k = 0; k < 2; ++k) dst[n][k] = *(const PG8_LAS bf16x8*)(lds + PG8_SB(b, h) + boff + n * 2048 + k * 1024); } while (0)
#define PG8_MMA(ai, bj, At, Bt) do { __builtin_amdgcn_s_setprio(1); _Pragma("unroll") for (int m = 0; m < 4; ++m) _Pragma("unroll") for (int n = 0; n < 2; ++n) _Pragma("unroll") for (int k = 0; k < 2; ++k) \
        acc[ai][bj][m][n] = __builtin_amdgcn_mfma_f32_16x16x32_bf16(Bt[n][k], At[m][k], acc[ai][bj][m][n], 0, 0, 0); __builtin_amdgcn_s_setprio(0); } while (0)
#define PG8_WAIT_V(n) asm volatile("s_waitcnt vmcnt(" #n ")" ::: "memory")
#define PG8_WAIT_L(n) asm volatile("s_waitcnt lgkmcnt(" #n ")" ::: "memory")
#define PG8_BAR __builtin_amdgcn_s_barrier()
#define PG8_SCHED __builtin_amdgcn_sched_barrier(0)
    Unit cur, nxt; int ui = 0;
    if (!S.next(0, cur)) return;
    f32x4 acc[2][2][4][2];
#pragma unroll
    for (int a = 0; a < 2; ++a)
#pragma unroll
        for (int b = 0; b < 2; ++b)
#pragma unroll
            for (int m = 0; m < 4; ++m)
#pragma unroll
                for (int n = 0; n < 2; ++n) acc[a][b][m][n] = (f32x4){0.f, 0.f, 0.f, 0.f};
    bf16x8 At[4][2], B0[2][2], B1[2][2];
    const char* cA = S.pa(g, cur, tstep); const char* cB = S.pb(g, cur, tstep);
    S.a_ready(cur);
    if constexpr (SP2) {
        PG8_STAGE(PG8_SB(0, 0), cB, voffB); PG8_STAGE(PG8_SB(0, 1), cB + hstep, voffB); PG8_STAGE(PG8_SA(0, 0), cA, voffA); PG8_STAGE(PG8_SA(0, 1), cA + hstep, voffA);
        if (wr == 1) PG8_BAR;
        PG8_WAIT_V(2); PG8_BAR;
        PG8_STAGE(PG8_SB(1, 0), cB + kstep, voffB); PG8_STAGE(PG8_SA(1, 0), cA + kstep, voffA); PG8_STAGE(PG8_SB(1, 1), cB + hstep + kstep, voffB);
        PG8_WAIT_V(6); PG8_BAR;
    } else {
        PG8_STAGE(PG8_SB(0, 0), cB, voffB); PG8_STAGE(PG8_SA(0, 0), cA, voffA); PG8_STAGE(PG8_SB(0, 1), cB + hstep, voffB); PG8_STAGE(PG8_SA(0, 1), cA + hstep, voffA);
        if (wr == 1) PG8_BAR;
        PG8_WAIT_V(4); PG8_BAR;
        PG8_STAGE(PG8_SB(1, 0), cB + kstep, voffB); PG8_STAGE(PG8_SA(1, 0), cA + kstep, voffA); PG8_STAGE(PG8_SB(1, 1), cB + hstep + kstep, voffB);
        PG8_WAIT_V(6); PG8_BAR;
    }
    for (;;) {
        const bool has_next = S.next(ui + 1, nxt);
        const char* nA = has_next ? S.pa(g, nxt, tstep) : cA; const char* nB = has_next ? S.pb(g, nxt, tstep) : cB;
        for (int t = 0; t < nt; t += 2) {
            const bool last = (t == nt - 2);
            const char* a1 = cA + (size_t)(t + 1) * kstep;
            const char* a2 = last ? nA : cA + (size_t)(t + 2) * kstep; const char* b2 = last ? nB : cB + (size_t)(t + 2) * kstep;
            const char* a3 = a2 + kstep; const char* b3 = b2 + kstep;
            if (last && has_next) S.a_ready(nxt);
            if constexpr (SP2) {
            PG8_LDB(B0, 0, 0); PG8_LDB(B1, 0, 1); PG8_SCHED; PG8_LDA(At, 0, 0); PG8_STAGE(PG8_SA(1, 1), a1 + hstep, voffA);
            PG8_WAIT_V(8); PG8_WAIT_L(0); PG8_BAR; PG8_MMA(0, 0, At, B0); PG8_MMA(0, 1, At, B1); PG8_BAR; PG8_SCHED;
            PG8_LDA(At, 0, 1); PG8_STAGE(PG8_SB(0, 0), b2, voffB); PG8_STAGE(PG8_SB(0, 1), b2 + hstep, voffB); PG8_STAGE(PG8_SA(0, 0), a2, voffA);
            PG8_WAIT_V(8); PG8_WAIT_L(0); PG8_BAR; PG8_MMA(1, 0, At, B0); PG8_MMA(1, 1, At, B1); PG8_BAR; PG8_SCHED;
            PG8_LDB(B0, 1, 0); PG8_LDB(B1, 1, 1); PG8_SCHED; PG8_LDA(At, 1, 0); PG8_STAGE(PG8_SA(0, 1), a2 + hstep, voffA);
            PG8_WAIT_V(8); PG8_WAIT_L(0); PG8_BAR; PG8_MMA(0, 0, At, B0); PG8_MMA(0, 1, At, B1); PG8_BAR; PG8_SCHED;
            PG8_LDA(At, 1, 1); PG8_STAGE(PG8_SB(1, 0), b3, voffB); PG8_STAGE(PG8_SB(1, 1), b3 + hstep, voffB); PG8_STAGE(PG8_SA(1, 0), a3, voffA);
            PG8_WAIT_V(8); PG8_WAIT_L(0); PG8_BAR; PG8_MMA(1, 0, At, B0); PG8_MMA(1, 1, At, B1); PG8_BAR; PG8_SCHED;
            } else {
            PG8_LDB(B0, 0, 0); PG8_SCHED; PG8_LDA(At, 0, 0); PG8_STAGE(PG8_SA(1, 1), a1 + hstep, voffA);
            PG8_WAIT_L(8); PG8_BAR; PG8_WAIT_L(0); PG8_MMA(0, 0, At, B0); PG8_BAR; PG8_SCHED;
            PG8_LDB(B1, 0, 1); PG8_STAGE(PG8_SB(0, 0), b2, voffB);
            PG8_BAR; PG8_WAIT_L(0); PG8_MMA(0, 1, At, B1); PG8_BAR;
            PG8_LDA(At, 0, 1); PG8_STAGE(PG8_SA(0, 0), a2, voffA);
            PG8_BAR; PG8_WAIT_L(0); PG8_MMA(1, 0, At, B0); PG8_BAR; PG8_SCHED;
            PG8_STAGE(PG8_SB(0, 1), b2 + hstep, voffB);
            PG8_WAIT_V(6); PG8_BAR; PG8_MMA(1, 1, At, B1); PG8_BAR;
            PG8_LDB(B0, 1, 0); PG8_SCHED; PG8_LDA(At, 1, 0); PG8_STAGE(PG8_SA(0, 1), a2 + hstep, voffA);
            PG8_WAIT_L(8); PG8_BAR; PG8_WAIT_L(0); PG8_MMA(0, 0, At, B0); PG8_BAR; PG8_SCHED;
            PG8_LDB(B1, 1, 1); PG8_STAGE(PG8_SB(1, 0), b3, voffB);
            PG8_BAR; PG8_WAIT_L(0); PG8_MMA(0, 1, At, B1); PG8_BAR;
            PG8_LDA(At, 1, 1); PG8_STAGE(PG8_SA(1, 0), a3, voffA);
            PG8_BAR; PG8_WAIT_L(0); PG8_MMA(1, 0, At, B0); PG8_BAR; PG8_SCHED;
            PG8_STAGE(PG8_SB(1, 1), b3 + hstep, voffB);
            PG8_WAIT_V(6); PG8_BAR; PG8_MMA(1, 1, At, B1); PG8_BAR;
            }
        }
        if constexpr (ALIGN_EPI) { if (wr == 0) PG8_BAR; }
        if constexpr (!Epi::AFTER_DRAIN) { E(acc, cur, wr, wc, fr, fq); S.done(cur); }
        if (!has_next) break;
#pragma unroll
        for (int a = 0; a < 2; ++a)
#pragma unroll
            for (int b = 0; b < 2; ++b)
#pragma unroll
                for (int m = 0; m < 4; ++m)
#pragma unroll
                    for (int n = 0; n < 2; ++n) acc[a][b][m][n] = (f32x4){0.f, 0.f, 0.f, 0.f};
        cur = nxt; cA = nA; cB = nB; ++ui;
        if constexpr (ALIGN_EPI) { if (wr == 1) PG8_BAR; }
    }
    PG8_WAIT_V(0);
    if constexpr (!ALIGN_EPI) { if (wr == 0) PG8_BAR; }
    PG8_BAR;
    if constexpr (Epi::AFTER_DRAIN) { E.fused(acc, cur, wr, wc, fr, fq, lds, wid, lane); S.done(cur); }
#undef PG8_SA
#undef PG8_SB
#undef PG8_STAGE
#undef PG8_LDA
#undef PG8_LDB
#undef PG8_MMA
#undef PG8_WAIT_V
#undef PG8_WAIT_L
#undef PG8_BAR
#undef PG8_SCHED
}
}
#define RLX_AGENT __ATOMIC_RELAXED, __HIP_MEMORY_SCOPE_AGENT
#define XB_TMO      128
#define XB_XCNT(j)  (256  + 64 * (j))
#define XB_XSUB(j)  (1280 + 64 * (j))
#define XB_XGEN(j)  (2304 + 64 * (j))
#define XB_TOP      3328
#define XB_TOPGEN   3392
#define XCD_BAR_WORDS 3456
#define XB_SPIN_CAP (1u << 18)

__device__ __forceinline__ unsigned xb_ld(unsigned* p)              { return __hip_atomic_load(p, __ATOMIC_RELAXED, __HIP_MEMORY_SCOPE_AGENT); }
__device__ __forceinline__ unsigned xb_add(unsigned* p, unsigned v) { return __hip_atomic_fetch_add(p, v, __ATOMIC_RELAXED, __HIP_MEMORY_SCOPE_AGENT); }
__device__ __forceinline__ unsigned xb_xcc_id() { return (unsigned)__builtin_amdgcn_s_getreg((3 << 11) | 20) & 0xFu; }
#define XB_SPIN(cond, bar) do { unsigned _sp = 0; while (cond) { __builtin_amdgcn_s_sleep(1); \
    if ((++_sp & 255u) == 0u) { if (xb_ld(&(bar)[XB_TMO])) break; if (_sp > XB_SPIN_CAP) { atomicAdd(&(bar)[XB_TMO], 1u); break; } } } } while (0)

struct XcdBarrier {
    unsigned* bar; unsigned x;
    volatile LAS unsigned* st;
};

__device__ __forceinline__ XcdBarrier xcd_barrier_post(unsigned* bar, volatile LAS unsigned* st) {
    XcdBarrier b; b.bar = bar; b.x = xb_xcc_id(); b.st = st;
    if (threadIdx.x == 0) (void)xb_add(&bar[XB_XCNT(b.x)], 1u);
    return b;
}
__device__ __forceinline__ void xcd_barrier_complete(unsigned* bar, unsigned x, unsigned& nloc, unsigned& nx) {
    const unsigned G = gridDim.x * gridDim.y * gridDim.z;
    unsigned sum, cnt, mine, sp = 0u;
    for (;;) {
        sum = 0u; cnt = 0u; mine = 0u;
#pragma unroll
        for (unsigned j = 0; j < 16; ++j) { const unsigned c = xb_ld(&bar[XB_XCNT(j)]); sum += c; cnt += (c > 0u) ? 1u : 0u; mine = (j == x) ? c : mine; }
        if (sum == G) break;
        __builtin_amdgcn_s_sleep(1);
        if ((++sp & 255u) == 0u) { if (xb_ld(&bar[XB_TMO])) break; if (sp > XB_SPIN_CAP) { atomicAdd(&bar[XB_TMO], 1u); break; } }
    }
    nloc = mine > 0u ? mine : 1u; nx = cnt > 0u ? cnt : 1u;
}

__device__ __forceinline__ void xcd_barrier(const XcdBarrier& b) {
    asm volatile("s_waitcnt vmcnt(0)" ::: "memory");
    __syncthreads();
    if (threadIdx.x == 0) {
        unsigned* bar = b.bar;
        __builtin_amdgcn_s_waitcnt(0);
        unsigned nloc = b.st[0], nx = b.st[1];
        if (nloc == 0u) { xcd_barrier_complete(bar, b.x, nloc, nx); b.st[0] = nloc; b.st[1] = nx; }
        const unsigned old = xb_add(&bar[XB_XSUB(b.x)], 1u);
        const unsigned gen = old / nloc;
        if (old + 1u == (gen + 1u) * nloc) {
            __builtin_amdgcn_fence(__ATOMIC_RELEASE, "agent");
            asm volatile("s_waitcnt vmcnt(0)" ::: "memory");
            const unsigned og = xb_add(&bar[XB_TOP], 1u);
            const unsigned tg = og / nx;
            if (og + 1u == (tg + 1u) * nx) xb_add(&bar[XB_TOPGEN], 1u);
            else XB_SPIN(xb_ld(&bar[XB_TOPGEN]) == tg, bar);
            __builtin_amdgcn_fence(__ATOMIC_ACQUIRE, "agent");
            xb_add(&bar[XB_XGEN(b.x)], 1u);
            asm volatile("s_waitcnt vmcnt(0)" ::: "memory");
        } else {
            XB_SPIN(xb_ld(&bar[XB_XGEN(b.x)]) == gen, bar);
            __builtin_amdgcn_fence(__ATOMIC_ACQUIRE, "agent");
            asm volatile("s_waitcnt vmcnt(0)" ::: "memory");
        }
    }
    __syncthreads();
}
struct Params {
    const float *x_prompt, *x_sample, *cache; const int* pt;
    const float *win_state, *conv_state, *hg_state, *tb, *g_mix, *g_mlp, *w_up, *w_dn, *w_in, *w_out, *q_g, *k_g, *cmp_pe, *cmp_w1, *cmp_b1, *cmp_w2,
                *conv_w, *conv_b, *ln_g, *ln_b, *hg_w_in, *hg_w_out, *hg_lb, *hg_ng;
    float* out; unsigned* ctl;
    bf16_t *Wt_in, *Wt_out0, *Wt_up0, *Wt_dn0, *Wt_hgin, *Wt_hgout, *Wt_up1, *Wt_dn1, *W1cmp;
    float *cbv, *lbv;
    bf16_t* xb; float *ssp0, *ssp1, *ssp2, *ssp3, *ssps1, *ssps2, *ssps3;
    bf16_t *Qs, *Kc, *VcT, *Ksel, *VselT, *Kwin, *VwinT, *KwinS, *VwinST, *KselSn, *VselSTn;
    float *proj, *glu, *qn, *kvw, *gates; bf16_t *ao, *aochk, *acmp, *glub; float *hfs, *kcvc, *x1, *x2, *x3; bf16_t* hid; float *hgp, *dS, *Dtot, *Sst, *og;
    int ph_lo, ph_hi;
};
constexpr int NWAVES = 8, NTHR = 512;
constexpr int LDS_BYTES = 163840, RING_BYTES = 131072, MISC_OFF = LDS_BYTES - 256;
constexpr int CW_BAR = 4096;
constexpr size_t CTL_BYTES = 1u << 20;

template <bool PERMIN = false>
__device__ __forceinline__ void transpose_item(const float* __restrict__ W, const float* __restrict__ g, int K, int N, bf16_t* __restrict__ WT, float* scr, int item, int nblk, int lane) {
    const int kb = item / nblk, nb = item % nblk, k0 = 64 * kb, n0o = 32 * nb; int n0 = n0o; if (PERMIN) { n0 = nat_col(n0o); if (n0 < 0) n0 = N; }
#pragma unroll 8
    for (int i = 0; i < 32; ++i) { const int kk = 2 * i + (lane >> 5), n = n0 + (lane & 31); float v = 0.f; if (n < N) { v = W[(size_t)(k0 + kk) * N + n]; if (g) v *= g[k0 + kk]; } scr[kk * 33 + (lane & 31)] = v; }
    LDS_WAIT(); asm volatile("" ::: "memory");
    const int c = lane & 7;
#pragma unroll
    for (int j = 0; j < 4; ++j) { const int n = (lane >> 3) + 8 * j; const float* s = scr + (8 * c) * 33 + n;
        v4u o; o.x = pk2(s[0 * 33], s[1 * 33]); o.y = pk2(s[2 * 33], s[3 * 33]); o.z = pk2(s[4 * 33], s[5 * 33]); o.w = pk2(s[6 * 33], s[7 * 33]);
        *(v4u*)(WT + (size_t)(n0o + n) * K + k0 + 8 * c) = o; }
    LDS_WAIT(); asm volatile("" ::: "memory");
}
__device__ __forceinline__ void p0_prologue(const Params& P, unsigned char* lds, int G, int repA, int repB, int repC) {
    const int tid = otid(), lane = tid & 63, wave = __builtin_amdgcn_readfirstlane(tid >> 6), gw = blockIdx.x * NWAVES + wave, NGW = G * NWAVES;
    float* scr = (float*)(lds + wave * 16384);
    constexpr int I_IN = (D / 64) * (NINP / 32), I_SQ = (D / 64) * (D / 32), I_UP = (D / 64) * (FF / 32), I_DN = (FF / 64) * (D / 32);
    constexpr int NITEMS = I_IN + 2 * I_SQ + 3 * I_UP + 2 * I_DN;
    for (int ra = 0; ra < repA; ++ra)
    for (int it = gw; it < NITEMS; it += NGW) {
        int r = it;
        if (r < I_IN) { transpose_item<true>(P.w_in, P.g_mix, D, NIN, P.Wt_in, scr, r, NINP / 32, lane); continue; } r -= I_IN;
        if (r < I_SQ) { transpose_item(P.w_out, nullptr, D, D, P.Wt_out0, scr, r, D / 32, lane); continue; } r -= I_SQ;
        if (r < I_SQ) { transpose_item(P.hg_w_out, nullptr, D, D, P.Wt_hgout, scr, r, D / 32, lane); continue; } r -= I_SQ;
        if (r < I_UP) { transpose_item(P.w_up, P.g_mlp, D, FF, P.Wt_up0, scr, r, FF / 32, lane); continue; } r -= I_UP;
        if (r < I_UP) { transpose_item(P.w_up + (size_t)D * FF, P.g_mlp + D, D, FF, P.Wt_up1, scr, r, FF / 32, lane); continue; } r -= I_UP;
        if (r < I_UP) { transpose_item(P.hg_w_in, P.g_mix + D, D, FF, P.Wt_hgin, scr, r, FF / 32, lane); continue; } r -= I_UP;
        if (r < I_DN) { transpose_item(P.w_dn, nullptr, FF, D, P.Wt_dn0, scr, r, D / 32, lane); continue; } r -= I_DN;
        transpose_item(P.w_dn + (size_t)D * FF, nullptr, FF, D, P.Wt_dn1, scr, r, D / 32, lane);
    }
    const int gt = blockIdx.x * NTHR + tid, NGT = G * NTHR;
    for (int idx = gt; idx < 2 * 256 * 1024; idx += NGT) {
        const int k = idx & 1023, n = (idx >> 10) & 255, kv = idx >> 18, s = k >> 6, d = k & 63, h = n >> 7, f = n & 127;
        P.W1cmp[idx] = (bf16_t)f2bf(P.cmp_w1[(((size_t)kv * 32 + 16 * h + s) * 64 + d) * 128 + f]);
    }
    for (int it = gw; it < 256; it += NGW) { const int kv = it >> 7, f = it & 127; float a = 0.f;
        for (int sd = lane; sd < 2048; sd += 64) a += P.cmp_pe[kv * 2048 + sd] * P.cmp_w1[((size_t)kv * 2048 + sd) * 128 + f];
        a = wave_sum(a); if (lane == 0) P.cbv[it] = a + P.cmp_b1[it]; }
    for (int c = gt; c < D; c += NGT) { const float l0 = P.hg_lb[c], l1 = P.hg_lb[D + c], m = fmaxf(l0, l1), e0 = __expf(l0 - m), e1 = __expf(l1 - m), s = e0 + e1; const float p0 = e0 / s, p1 = e1 / s; P.lbv[c] = (p0 + p1) - p0; }
    for (int rc = 0; rc < repC; ++rc)
    for (int row = gw; row < MR; row += NGW) {
        const float* xr = row < TP ? P.x_prompt + (size_t)row * D : P.x_sample + (size_t)(row - TP) * D; bf16_t* o = P.xb + (size_t)row * D;
        float s = 0.f;
#pragma unroll
        for (int j = 0; j < 4; ++j) { const f32x4 v = *(const f32x4*)(xr + 4 * lane + 256 * j); s += (v.x * v.x + v.y * v.y) + (v.z * v.z + v.w * v.w); v2u w; w.x = pk2(v.x, v.y); w.y = pk2(v.z, v.w); *(v2u*)(o + 4 * lane + 256 * j) = w; }
        s = wave_sum(s);
        if (lane < 16) P.ssp0[(size_t)row * 16 + lane] = lane == 0 ? s : 0.f;
    }
    for (int rb = 0; rb < repB; ++rb)
    for (int it0 = gw; it0 < 2 * 32 * 1024; it0 += 2 * NGW) {
        const int tp = lane >> 5, pc = lane & 31, hkvl = pc >> 4, dq = (pc & 15) * 4;
        f32x4 v[2][8]; bf16_t* dst[2];
#pragma unroll
        for (int u = 0; u < 2; ++u) { const int it = it0 + u * NGW, c = it & 1023, b = (it >> 10) & 31, kv = it >> 15;
            const int page = P.pt[b * NPAGES + (c >> 3)];
            const float* src = P.cache + (((size_t)page * 128 + (c & 7) * 16 + tp) * 4 + kv) * 128 + pc * 4;
            dst[u] = P.acmp + ((size_t)kv * CMPROWS + ((size_t)(b + 1) * 2 + hkvl) * 1024 + c) * 1024 + tp * 64 + dq;
#pragma unroll
            for (int s = 0; s < 8; ++s) v[u][s] = *(const f32x4*)(src + (size_t)s * 1024); }
#pragma unroll
        for (int u = 0; u < 2; ++u)
#pragma unroll
            for (int s = 0; s < 8; ++s) { v2u w; w.x = pk2(v[u][s].x, v[u][s].y); w.y = pk2(v[u][s].z, v[u][s].w); *(v2u*)(dst[u] + s * 128) = w; }
    }
    for (int idx = gt; idx < 32 * 512 * 256; idx += NGT) { const int dd = idx & 63, hkv = (idx >> 6) & 1, kv = (idx >> 7) & 1, i = (idx >> 8) & 511, b = idx >> 17; const bf16_t x = (bf16_t)f2bf(P.win_state[idx]);
        if (kv == 0) P.KwinS[((size_t)(b * 2 + hkv) * 544 + i) * 64 + dd] = x; else P.VwinST[((size_t)(b * 2 + hkv) * 64 + dd) * 544 + i] = x; }
    for (int idx = gt; idx < 32 * 508 * 256; idx += NGT) { const int b = idx / (508 * 256), r = idx % (508 * 256); P.out[OFF_WINS + (size_t)b * 512 * 256 + r] = P.win_state[(size_t)b * 512 * 256 + 4 * 256 + r]; }
    for (int idx = gt; idx < 32 * 26 * 512; idx += NGT) { const int b = idx / (26 * 512), r = idx % (26 * 512); P.out[OFF_CONVS + (size_t)b * 30 * 512 + r] = P.conv_state[(size_t)b * 30 * 512 + 4 * 512 + r]; }
}

struct SEpProj { float* proj; const float* ssp; static constexpr bool STATS = false; __device__ __forceinline__ void stat(int, int, float) const {}
    __device__ __forceinline__ f32x4 operator()(int m, int n, f32x4 a) const { const int nn = nat_col(n); if (nn >= 0) *(f32x4*)(proj + (size_t)m * NIN + nn) = a * row_r(ssp, m); return a; } };
struct SEpResid { const float* xin; float* out; bf16_t* xb; float* ssps; int xoff; int pad; static constexpr bool STATS = true;
    __device__ __forceinline__ f32x4 operator()(int m, int n, f32x4 a) const { const f32x4 o = *(const f32x4*)(xin + (size_t)(m - xoff) * D + n) + a; *(f32x4*)(out + (size_t)m * D + n) = o;
        if (xb) { v2u w; w.x = pk2(o[0], o[1]); w.y = pk2(o[2], o[3]); *(v2u*)(xb + (size_t)m * D + n) = w; } return o; }
    __device__ __forceinline__ void stat(int row, int slab, float q) const { if (ssps) ssps[(size_t)row * 64 + slab] = q; } };
struct SEpUp { bf16_t* hid; const float* rtab; static constexpr bool STATS = false; __device__ __forceinline__ void stat(int, int, float) const {}
    __device__ __forceinline__ f32x4 operator()(int m, int n, f32x4 a) const { const float r = rtab[m - TP]; f32x4 v;
#pragma unroll
        for (int i = 0; i < 4; ++i) { const float t = fmaxf(a[i] * r, 0.f); v[i] = t * t; }
        v2u w; w.x = pk2(v[0], v[1]); w.y = pk2(v[2], v[3]); *(v2u*)(hid + (size_t)m * FF + n) = w; return a; } };
struct SEpScale { float* out; const float* rtab; int ld; int pad; static constexpr bool STATS = false; __device__ __forceinline__ void stat(int, int, float) const {}
    __device__ __forceinline__ f32x4 operator()(int m, int n, f32x4 a) const { *(f32x4*)(out + (size_t)m * ld + n) = a * rtab[m - TP]; return a; } };
__device__ __forceinline__ void sample_rtab(const float* __restrict__ ssps, float* rtab) {
    const int tid = otid();
    if (tid < SR) { float s = 0.f; const f32x4* p = (const f32x4*)(ssps + (size_t)tid * 64);
#pragma unroll
        for (int j = 0; j < 16; ++j) { const f32x4 v = p[j]; s += (v.x + v.y) + (v.z + v.w); }
        rtab[tid] = rsqrtf(s * (1.f / D) + EPS); }
    __syncthreads();
}
template <class EP>
__device__ __forceinline__ void sgemm_mfma(const bf16_t* __restrict__ A, const bf16_t* __restrict__ Bt, int N, int K, const EP& ep, unsigned char* lds, int G) {
    typedef short bf16x8_ __attribute__((ext_vector_type(8)));
    const int tid = otid(), wave = __builtin_amdgcn_readfirstlane(tid >> 6), lane = tid & 63, c = lane & 15, rq = lane >> 4;
    float* part = (float*)lds;
    const int kper = K / NWAVES, kbeg = wave * kper;
    for (int it = blockIdx.x; it < N / 16; it += G) {
        const int n0 = it * 16;
        f32x4 acc[8];
#pragma unroll
        for (int rt = 0; rt < 8; ++rt) acc[rt] = (f32x4){0.f, 0.f, 0.f, 0.f};
        const bf16_t* bp = Bt + (size_t)(n0 + c) * K + kbeg + rq * 8; const bf16_t* ap = A + (size_t)(TP + c) * K + kbeg + rq * 8;
        for (int k = 0; k < kper; k += 64) {
            bf16x8_ b0 = *(const bf16x8_*)(bp + k), b1 = *(const bf16x8_*)(bp + k + 32); bf16x8_ a0[8], a1[8];
#pragma unroll
            for (int rt = 0; rt < 8; ++rt) { a0[rt] = *(const bf16x8_*)(ap + (size_t)rt * 16 * K + k); a1[rt] = *(const bf16x8_*)(ap + (size_t)rt * 16 * K + k + 32); }
#pragma unroll
            for (int rt = 0; rt < 8; ++rt) { acc[rt] = __builtin_amdgcn_mfma_f32_16x16x32_bf16(a0[rt], b0, acc[rt], 0, 0, 0); acc[rt] = __builtin_amdgcn_mfma_f32_16x16x32_bf16(a1[rt], b1, acc[rt], 0, 0, 0); }
        }
#pragma unroll
        for (int rt = 0; rt < 8; ++rt)
#pragma unroll
            for (int i = 0; i < 4; ++i) part[(wave * 128 + rt * 16 + 4 * rq + i) * 16 + c] = acc[rt][i];
        __syncthreads();
        { const int row = tid >> 2, cg = (tid & 3) * 4; f32x4 s = *(const f32x4*)(part + row * 16 + cg);
#pragma unroll
            for (int w = 1; w < 8; ++w) s = s + *(const f32x4*)(part + (w * 128 + row) * 16 + cg);
            const f32x4 o = ep(TP + row, n0 + cg, s);
            if (EP::STATS) { float q = (o[0] * o[0] + o[1] * o[1]) + (o[2] * o[2] + o[3] * o[3]); q += __shfl_xor(q, 1); q += __shfl_xor(q, 2); if ((tid & 3) == 0) ep.stat(row, it, q); } }
        __syncthreads();
    }
}

__device__ __forceinline__ float grp8_sum(float x) { x += __shfl_xor(x, 1); x += __shfl_xor(x, 2); x += __shfl_xor(x, 4); return x; }
__device__ __forceinline__ void p2_sample(const Params& P, int G) {
    const int tid = otid(), wave = __builtin_amdgcn_readfirstlane(tid >> 6), lane = tid & 63, l8 = lane * 8;
    float* out = P.out;
    for (int rr = blockIdx.x * NWAVES + wave; rr < SR; rr += G * NWAVES) {
        const int m = TP + rr, b = rr >> 2, tt = rr & 3;
        const float* p = P.proj + (size_t)m * NIN;
        { const f32x4 a0 = *(const f32x4*)(p + l8), a1 = *(const f32x4*)(p + l8 + 4), g0 = *(const f32x4*)(p + CC + l8), g1 = *(const f32x4*)(p + CC + l8 + 4); f32x4 o0, o1;
#pragma unroll
          for (int i = 0; i < 4; ++i) { o0[i] = a0[i] * sigmoidf_(g0[i]); o1[i] = a1[i] * sigmoidf_(g1[i]); }
          float* cs = out + OFF_CONVS + ((size_t)b * 30 + 26 + tt) * CC + l8; *(f32x4*)cs = o0; *(f32x4*)(cs + 4) = o1; }
        { f32x4 v0 = *(const f32x4*)(p + 1024 + l8), v1 = *(const f32x4*)(p + 1024 + l8 + 4);
          float s = ((v0[0] * v0[0] + v0[1] * v0[1]) + (v0[2] * v0[2] + v0[3] * v0[3])) + ((v1[0] * v1[0] + v1[1] * v1[1]) + (v1[2] * v1[2] + v1[3] * v1[3]));
          s = grp8_sum(s); const float rs = rsqrtf(s * (1.f / 64.f) + EPS) * (0.125f * 1.4426950408889634f); const int dq = (lane & 7) * 8;
          v0 = v0 * rs * *(const f32x4*)(P.q_g + dq); v1 = v1 * rs * *(const f32x4*)(P.q_g + dq + 4);
          v4u w; w.x = pk2(v0[0], v0[1]); w.y = pk2(v0[2], v0[3]); w.z = pk2(v1[0], v1[1]); w.w = pk2(v1[2], v1[3]); *(v4u*)(P.Qs + (size_t)m * 512 + l8) = w; }
#pragma unroll
        for (int pass = 0; pass < 2; ++pass) {
            if (pass == 1 && lane >= 32) break;
            const int col = pass * 512 + l8, gi = col >> 6, dq = col & 63, s = gi >> 2, kv01 = (gi >> 1) & 1, hkv = gi & 1, bh = b * 2 + hkv;
            f32x4 v0 = *(const f32x4*)(p + 1536 + col), v1 = *(const f32x4*)(p + 1536 + col + 4);
            float ss = ((v0[0] * v0[0] + v0[1] * v0[1]) + (v0[2] * v0[2] + v0[3] * v0[3])) + ((v1[0] * v1[0] + v1[1] * v1[1]) + (v1[2] * v1[2] + v1[3] * v1[3]));
            ss = grp8_sum(ss);
            if (kv01 == 0 && s >= 1) { const float rs = rsqrtf(ss * (1.f / 64.f) + EPS); v0 = v0 * rs * *(const f32x4*)(P.k_g + s * 64 + dq); v1 = v1 * rs * *(const f32x4*)(P.k_g + s * 64 + dq + 4); }
            v4u wb; wb.x = pk2(v0[0], v0[1]); wb.y = pk2(v0[2], v0[3]); wb.z = pk2(v1[0], v1[1]); wb.w = pk2(v1[2], v1[3]);
            float* o = s < 2 ? out + OFF_KVS + ((size_t)rr * 4 + s * 2 + kv01) * 128 + hkv * 64 + dq : out + OFF_WINS + (((size_t)b * 512 + 508 + tt) * 2 + kv01) * 128 + hkv * 64 + dq;
            *(f32x4*)o = v0; *(f32x4*)(o + 4) = v1;
            if (s >= 1) { const unsigned ww[4] = {wb.x, wb.y, wb.z, wb.w};
                if (kv01 == 0) *(v4u*)((s == 1 ? P.KselSn + ((size_t)bh * 64 + tt) * 64 : P.KwinS + ((size_t)bh * 544 + 512 + tt) * 64) + dq) = wb;
                else {
#pragma unroll
                    for (int e = 0; e < 8; ++e) { const bf16_t x = (bf16_t)((ww[e >> 1] >> ((e & 1) * 16)) & 0xffff);
                        if (s == 1) P.VselSTn[((size_t)bh * 64 + dq + e) * 64 + tt] = x; else P.VwinST[((size_t)bh * 64 + dq + e) * 544 + 512 + tt] = x; } } }
        }
        if (lane < 24) P.gates[(size_t)m * 24 + lane] = sigmoidf_(p[2304 + lane]);
    }
}
__device__ __forceinline__ void p2_check(const Params& P, int G) {
    const int tid = otid(), wave = __builtin_amdgcn_readfirstlane(tid >> 6), lane = tid & 63;
    for (int m = blockIdx.x * NWAVES + wave; m < MR; m += G * NWAVES) {
        const float* p = P.proj + (size_t)m * NIN;
        for (int hh = 0; hh < 8; ++hh) { const float v = p[1024 + hh * 64 + lane]; const float s = wave_sum(v * v); P.qn[(size_t)m * 512 + hh * 64 + lane] = v * rsqrtf(s * (1.f / 64.f) + EPS) * P.q_g[lane]; }
        for (int gi = 0; gi < 12; ++gi) { const int s = gi >> 2, kv01 = (gi >> 1) & 1; float v = p[1536 + gi * 64 + lane];
            if (kv01 == 0 && s >= 1) { const float q = wave_sum(v * v); v = v * rsqrtf(q * (1.f / 64.f) + EPS) * P.k_g[s * 64 + lane]; }
            P.kvw[(size_t)m * 768 + gi * 64 + lane] = v; }
    }
}
__device__ __forceinline__ void p3_conv(const Params& P, unsigned char* lds, int G) {
    float* wl = (float*)lds;
    const int tid = otid(), wave = __builtin_amdgcn_readfirstlane(tid >> 6), lane = tid & 63, c0 = lane * 8;
    for (int i = tid; i < CWID * CC; i += NTHR) wl[i] = P.conv_w[i];
    __syncthreads();
    f32x4 cb0 = *(const f32x4*)(P.conv_b + c0), cb1 = *(const f32x4*)(P.conv_b + c0 + 4), lg0 = *(const f32x4*)(P.ln_g + c0), lg1 = *(const f32x4*)(P.ln_g + c0 + 4), lb0 = *(const f32x4*)(P.ln_b + c0), lb1 = *(const f32x4*)(P.ln_b + c0 + 4);
    for (int rg = blockIdx.x * NWAVES + wave; rg < MR / 8; rg += G * NWAVES) {
#pragma unroll 1
        for (int k = 0; k < 8; ++k) {
            const int m = rg * 8 + k;
            f32x4 a0 = cb0, a1 = cb1;
            if (m < TP) {
                const int w0 = m < 30 ? 30 - m : 0;
#pragma unroll 4
                for (int w = w0; w < CWID; ++w) { const v4u xb_ = *(const v4u*)(P.glub + (size_t)(m - 30 + w) * CC + c0);
                    const f32x4 x0 = (f32x4){__uint_as_float(xb_.x << 16), __uint_as_float(xb_.x & 0xffff0000u), __uint_as_float(xb_.y << 16), __uint_as_float(xb_.y & 0xffff0000u)};
                    const f32x4 x1 = (f32x4){__uint_as_float(xb_.z << 16), __uint_as_float(xb_.z & 0xffff0000u), __uint_as_float(xb_.w << 16), __uint_as_float(xb_.w & 0xffff0000u)};
                    a0 = a0 + x0 * *(const f32x4*)(wl + w * CC + c0); a1 = a1 + x1 * *(const f32x4*)(wl + w * CC + c0 + 4); }
            } else { const int b = (m - TP) >> 2, tt = (m - TP) & 3;
#pragma unroll 1
                for (int w = 0; w < CWID; ++w) { const int i = tt + w; f32x4 x0, x1;
                    if (i < 30) { const float* x = P.conv_state + ((size_t)b * 30 + i) * CC + c0; x0 = *(const f32x4*)x; x1 = *(const f32x4*)(x + 4); }
                    else { const float* pp = P.proj + (size_t)(TP + 4 * b + (i - 30)) * NIN + c0; const f32x4 p0 = *(const f32x4*)pp, p1 = *(const f32x4*)(pp + 4), g0 = *(const f32x4*)(pp + CC), g1 = *(const f32x4*)(pp + CC + 4);
#pragma unroll
                        for (int q = 0; q < 4; ++q) { x0[q] = p0[q] * sigmoidf_(g0[q]); x1[q] = p1[q] * sigmoidf_(g1[q]); } }
                    a0 = a0 + x0 * *(const f32x4*)(wl + w * CC + c0); a1 = a1 + x1 * *(const f32x4*)(wl + w * CC + c0 + 4); }
            }
            const float mean = wave_sum(((a0.x + a0.y) + (a0.z + a0.w)) + ((a1.x + a1.y) + (a1.z + a1.w))) * (1.f / CC);
            a0 = a0 - mean; a1 = a1 - mean;
            const float var = wave_sum(((a0.x * a0.x + a0.y * a0.y) + (a0.z * a0.z + a0.w * a0.w)) + ((a1.x * a1.x + a1.y * a1.y) + (a1.z * a1.z + a1.w * a1.w))) * (1.f / CC);
            const float rs = rsqrtf(var + EPS);
            f32x4 z0 = a0 * rs * lg0 + lb0, z1 = a1 * rs * lg1 + lb1;
#pragma unroll
            for (int i = 0; i < 4; ++i) { z0[i] = z0[i] * sigmoidf_(z0[i]); z1[i] = z1[i] * sigmoidf_(z1[i]); }
            v4u o; o.x = pk2(z0.x, z0.y); o.y = pk2(z0.z, z0.w); o.z = pk2(z1.x, z1.y); o.w = pk2(z1.z, z1.w);
            *(v4u*)(P.ao + (size_t)m * D + c0) = o;
        }
    }
    __syncthreads();
}
__device__ __forceinline__ void p4_cmp_finish(const Params& P, unsigned char* lds, int G) {
    typedef short bf16x8_ __attribute__((ext_vector_type(8)));
    const int tid = otid(), wave = __builtin_amdgcn_readfirstlane(tid >> 6), lane = tid & 63, c = lane & 15, rq = lane >> 4;
    bf16_t* W2T = (bf16_t*)lds;
    for (int i = tid; i < 2 * 128 * 64; i += NTHR) { const int kv = i >> 13, f = (i >> 6) & 127, d = i & 63; W2T[(kv * 64 + d) * 136 + f] = (bf16_t)f2bf(P.cmp_w2[i]); }
    __syncthreads();
    constexpr int NGRP = 64, NIT = 2 * 66 * NGRP;
    for (int it = blockIdx.x * NWAVES + wave; it < NIT; it += G * NWAVES) {
        const int grp = it & 63, sh = (it >> 6) % 66, kv01 = it / (64 * 66);
        const float* hfs = P.hfs + (size_t)kv01 * CMPROWS * 256;
        const int j = grp * 16 + c;
        const bool jok = j < NCMP;
        bf16x8_ af[4];
#pragma unroll
        for (int ks = 0; ks < 4; ++ks) { const int f0 = ks * 32 + rq * 8; float x[8];
            if (jok) { const float* h1 = hfs + ((size_t)sh * 1024 + j) * 256 + f0; const float* h2 = hfs + ((size_t)sh * 1024 + j + 1) * 256 + 128 + f0; const float* cb = P.cbv + kv01 * 128 + f0;
                const f32x4 a0 = *(const f32x4*)h1, a1 = *(const f32x4*)(h1 + 4), b0 = *(const f32x4*)h2, b1 = *(const f32x4*)(h2 + 4), c0 = *(const f32x4*)cb, c1 = *(const f32x4*)(cb + 4);
#pragma unroll
                for (int i = 0; i < 4; ++i) { x[i] = a0[i] + b0[i] + c0[i]; x[4 + i] = a1[i] + b1[i] + c1[i]; } }
            else {
#pragma unroll
                for (int i = 0; i < 8; ++i) x[i] = 0.f; }
#pragma unroll
            for (int i = 0; i < 8; ++i) { const float u = 0.7978845608028654f * (x[i] + 0.044715f * x[i] * x[i] * x[i]); const float th = 1.f - 2.f / (1.f + __expf(2.f * u)); x[i] = 0.5f * x[i] * (1.f + th); }
            v4u w; w.x = pk2(x[0], x[1]); w.y = pk2(x[2], x[3]); w.z = pk2(x[4], x[5]); w.w = pk2(x[6], x[7]); af[ks] = __builtin_bit_cast(bf16x8_, w); }
        f32x4 o[4];
#pragma unroll
        for (int dt = 0; dt < 4; ++dt) { o[dt] = (f32x4){0.f, 0.f, 0.f, 0.f};
#pragma unroll
            for (int ks = 0; ks < 4; ++ks) o[dt] = __builtin_amdgcn_mfma_f32_16x16x32_bf16(af[ks], *(const bf16x8_*)(W2T + (kv01 * 64 + dt * 16 + c) * 136 + ks * 32 + rq * 8), o[dt], 0, 0, 0); }
        const int seq = sh >> 1, hkv = sh & 1;
#pragma unroll
        for (int i = 0; i < 4; ++i) {
            const int jj = grp * 16 + 4 * rq + i;
            float v[4] = {o[0][i], o[1][i], o[2][i], o[3][i]};
            if (kv01 == 0) { float s = (v[0] * v[0] + v[1] * v[1]) + (v[2] * v[2] + v[3] * v[3]); s += __shfl_xor(s, 1); s += __shfl_xor(s, 2); s += __shfl_xor(s, 4); s += __shfl_xor(s, 8);
                const float rs = rsqrtf(s * (1.f / 64.f) + EPS);
#pragma unroll
                for (int dt = 0; dt < 4; ++dt) v[dt] = v[dt] * rs * P.k_g[dt * 16 + c]; }
            if (jj < NCMP) {
#pragma unroll
                for (int dt = 0; dt < 4; ++dt) { const int d = dt * 16 + c;
#if NSA_CHECK
                    P.kcvc[((((size_t)seq * 2 + kv01) * 2 + hkv) * 1024 + jj) * 64 + d] = v[dt];
#endif
                    if (kv01 == 0) P.Kc[(((size_t)seq * 2 + hkv) * 1024 + jj) * 64 + d] = (bf16_t)f2bf(v[dt]); else P.VcT[((((size_t)seq * 2 + hkv) * 32 + (jj >> 5)) * 64 + d) * 32 + (jj & 31)] = (bf16_t)f2bf(v[dt]); }
            }
        }
    }
    __syncthreads();
}
struct NsaLds { const float* kp[1024]; const float* vp[1024]; int dist[1024]; float lg[4][1024]; float imp[1032]; float sc[264]; int sel[16]; float qs[4][64]; int lut[128]; };
static_assert(2 * sizeof(NsaLds) <= RING_BYTES, "NSA LDS");
__device__ __forceinline__ float nsa_attend(int nk, NsaLds* L, const float* tbh, int tid) {
    for (int i = tid; i < nk; i += 256) {
        const int dd = L->dist[i];
        if (dd >= 0) { const float* k = L->kp[i]; float a0 = 0.f, a1 = 0.f, a2 = 0.f, a3 = 0.f;
            for (int d = 0; d < 64; d += 4) { const f32x4 kv = *(const f32x4*)(k + d);
#pragma unroll
                for (int e = 0; e < 4; ++e) { a0 += L->qs[0][d + e] * kv[e]; a1 += L->qs[1][d + e] * kv[e]; a2 += L->qs[2][d + e] * kv[e]; a3 += L->qs[3][d + e] * kv[e]; } }
            const int bk = L->lut[dd < 127 ? dd : 127];
            L->lg[0][i] = a0 + tbh[bk * 8 + 0]; L->lg[1][i] = a1 + tbh[bk * 8 + 1]; L->lg[2][i] = a2 + tbh[bk * 8 + 2]; L->lg[3][i] = a3 + tbh[bk * 8 + 3];
        } else { L->lg[0][i] = -3e38f; L->lg[1][i] = -3e38f; L->lg[2][i] = -3e38f; L->lg[3][i] = -3e38f; }
    }
    __syncthreads();
    { const int g = tid >> 6, lane = tid & 63;
        float mx = -3e38f; for (int i = lane; i < nk; i += 64) mx = fmaxf(mx, L->lg[g][i]);
        mx = wave_max(mx);
        float sm = 0.f; for (int i = lane; i < nk; i += 64) { const float l = L->lg[g][i]; sm += (l > -1e38f) ? __expf(l - mx) : 0.f; }
        sm = wave_sum(sm);
        const float inv = 1.f / fmaxf(sm, 1e-30f);
        for (int i = lane; i < nk; i += 64) { const float l = L->lg[g][i]; L->lg[g][i] = (l > -1e38f) ? __expf(l - mx) * inv : 0.f; }
    }
    __syncthreads();
    const int g = tid >> 6, d = tid & 63; float a = 0.f;
    for (int i = 0; i < nk; ++i) { const float p = L->lg[g][i]; if (p != 0.f) a += p * L->vp[i][d]; }
    return a;
}
template <int CHK>
__device__ __forceinline__ void p5_nsa(const Params& P, unsigned char* lds, int G) {
    const int tid = otid() & 255, hkv = otid() >> 8;
    NsaLds* L = (NsaLds*)lds + hkv;
    if (tid < 128) { int n = tid, bk; if (n < 16) bk = n; else { const float v = logf((float)n / 16.f) / 2.0794415416798357f * 16.f; bk = 16 + (int)v; if (bk > 31) bk = 31; } L->lut[tid] = bk; }
    const float* tbh = P.tb + hkv * 4;
    const float* dummy = P.qn;
    for (int it = blockIdx.x; it < (CHK ? 512 : SR); it += G) {
        const int m = CHK ? (it < 64 ? it : (it < 96 ? 1000 + it : (it < 384 ? (it * 613 + 7) & 16383 : TP + (it - 384)))) : TP + it;
        const int seq = m < TP ? 0 : 1 + ((m - TP) >> 2), b = seq - 1;
        const int q_pos = m < TP ? m : PAST + ((m - TP) & 3);
        __syncthreads();
        L->qs[tid >> 6][tid & 63] = P.qn[(size_t)m * 512 + hkv * 256 + tid] * 0.125f;
        const int ncv = q_pos >= 31 ? min(NCMP, (q_pos - 31) / 16 + 1) : 0;
        const float* kcb = P.kcvc + (((size_t)seq * 2 + 0) * 2 + hkv) * 1024 * 64; const float* vcb = P.kcvc + (((size_t)seq * 2 + 1) * 2 + hkv) * 1024 * 64;
        for (int i = tid; i < ncv; i += 256) { L->kp[i] = kcb + (size_t)i * 64; L->vp[i] = vcb + (size_t)i * 64; L->dist[i] = q_pos - (16 * i + 31); }
        __syncthreads();
        const float oc = nsa_attend(ncv, L, tbh, tid);
        __syncthreads();
        for (int i = tid; i < 1032; i += 256) L->imp[i] = i < ncv ? (L->lg[0][i] + L->lg[1][i]) + (L->lg[2][i] + L->lg[3][i]) : 0.f;
        __syncthreads();
        const int ns = seq == 0 ? 256 : 257, cur = q_pos >> 6;
        for (int j = tid; j < ns; j += 256) {
            float s = 0.f;
            { const int i0 = 4 * j; if (i0 < NCMP) s += L->imp[i0]; if (i0 - 1 >= 0 && i0 - 1 < NCMP) s += L->imp[i0 - 1]; if (i0 + 1 < NCMP) s += L->imp[i0 + 1]; if (i0 < NCMP) s += L->imp[i0];
              if (i0 + 2 < NCMP) s += L->imp[i0 + 2]; if (i0 + 1 < NCMP) s += L->imp[i0 + 1]; if (i0 + 3 < NCMP) s += L->imp[i0 + 3]; if (i0 + 2 < NCMP) s += L->imp[i0 + 2]; }
            const bool forced = (j == 0) || (j == cur) || (j == cur - 1), valid = (j * 64 <= q_pos);
            if (forced) s = 1e9f; if (!valid) s = -1e9f;
            L->sc[j] = s;
        }
        __syncthreads();
        for (int j = tid; j < ns; j += 256) { const float sj = L->sc[j]; int rank = 0; for (int i = 0; i < ns; ++i) { const float si = L->sc[i]; rank += (si > sj || (si == sj && i < j)) ? 1 : 0; } if (rank < 16) L->sel[rank] = j; }
        __syncthreads();
        for (int i = tid; i < 1024; i += 256) {
            const int blk = L->sel[i >> 6], pos = blk * 64 + (i & 63); const int dd = q_pos - pos; L->dist[i] = dd;
            const float *k = dummy, *v = dummy;
            if (dd >= 0) {
                if (seq == 0) { k = P.kvw + (size_t)pos * 768 + (4 + hkv) * 64; v = k + 128; }
                else if (pos < PAST) { const int page = P.pt[b * NPAGES + (pos >> 7)]; k = P.cache + (((size_t)page * 128 + (pos & 127)) * 4 + 2) * 128 + hkv * 64; v = k + 128; }
                else { k = P.kvw + (size_t)(TP + 4 * b + (pos - PAST)) * 768 + (4 + hkv) * 64; v = k + 128; }
            }
            L->kp[i] = k; L->vp[i] = v;
        }
        __syncthreads();
        const float os = nsa_attend(1024, L, tbh, tid);
        __syncthreads();
        for (int i = tid; i < 513; i += 256) {
            const int pos = q_pos - 512 + i; int dd = 512 - i; const float *k = dummy, *v = dummy;
            if (pos < 0) dd = -1;
            else if (seq == 0) { k = P.kvw + (size_t)pos * 768 + (8 + hkv) * 64; v = k + 128; }
            else if (pos < PAST) { k = P.win_state + (((size_t)b * 512 + (pos - (PAST - 512))) * 2) * 128 + hkv * 64; v = k + 128; }
            else { k = P.kvw + (size_t)(TP + 4 * b + (pos - PAST)) * 768 + (8 + hkv) * 64; v = k + 128; }
            L->kp[i] = k; L->vp[i] = v; L->dist[i] = dd;
        }
        __syncthreads();
        const float ow = nsa_attend(513, L, tbh, tid);
        const int g = tid >> 6, d = tid & 63; const float* gt = P.gates + (size_t)m * 24 + (hkv * 4 + g) * 3;
        (CHK ? P.aochk : P.ao)[(size_t)m * D + 512 + (hkv * 4 + g) * 64 + d] = (bf16_t)f2bf(gt[0] * oc + gt[1] * os + gt[2] * ow);
        if (CHK) {
            __syncthreads();
            if (otid() < 64) { float se = 0.f, sr = 0.f;
                for (int i = otid(); i < 512; i += 64) { const float a = bf2f(P.ao[(size_t)m * D + 512 + i]), r = bf2f(P.aochk[(size_t)m * D + 512 + i]); se += (a - r) * (a - r); sr += r * r; }
                se = wave_sum(se); sr = wave_sum(sr);
                if (otid() == 0) { unsigned* cc = P.ctl + 16 + (m >= TP ? 8 : 0); atomicAdd(cc, 1u); if (se > 0.0025f * sr) atomicAdd(cc + 1, 1u); if (se > 0.0004f * sr) atomicAdd(cc + 2, 1u); if (!(se <= 0.25f * sr)) atomicAdd(cc + 3, 1u); } }
        }
    }
}

typedef short bf16x8 __attribute__((ext_vector_type(8)));
#define MFMA16(a, b, c) __builtin_amdgcn_mfma_f32_16x16x32_bf16((a), (b), (c), 0, 0, 0)
constexpr float LOG2E = 1.4426950408889634f;
__device__ __forceinline__ bf16x8 pack8(const float (&e)[8]) {
    v4u p; p.x = pg8::cvt_pk_bf16(e[0], e[1]); p.y = pg8::cvt_pk_bf16(e[2], e[3]); p.z = pg8::cvt_pk_bf16(e[4], e[5]); p.w = pg8::cvt_pk_bf16(e[6], e[7]);
    return __builtin_bit_cast(bf16x8, p);
}
__device__ __forceinline__ float dpp_xor1(float x) { return __builtin_bit_cast(float, __builtin_amdgcn_update_dpp(0, __builtin_bit_cast(int, x), 0xB1, 0xF, 0xF, true)); }
__device__ __forceinline__ float dpp_xor2(float x) { return __builtin_bit_cast(float, __builtin_amdgcn_update_dpp(0, __builtin_bit_cast(int, x), 0x4E, 0xF, 0xF, true)); }
__device__ __forceinline__ unsigned long long wave_max_u64(unsigned long long v) {
    unsigned lo = (unsigned)v, hi = (unsigned)(v >> 32);
#define WMX_STEP(ctrl, rmask) do { const unsigned lo2 = (unsigned)__builtin_amdgcn_update_dpp(0, (int)lo, ctrl, rmask, 0xf, false), hi2 = (unsigned)__builtin_amdgcn_update_dpp(0, (int)hi, ctrl, rmask, 0xf, false); \
        const bool gt = (hi2 > hi) || (hi2 == hi && lo2 > lo); lo = gt ? lo2 : lo; hi = gt ? hi2 : hi; } while (0)
    WMX_STEP(0x111, 0xf); WMX_STEP(0x112, 0xf); WMX_STEP(0x114, 0xf); WMX_STEP(0x118, 0xf); WMX_STEP(0x142, 0xa); WMX_STEP(0x143, 0xc);
#undef WMX_STEP
    lo = (unsigned)__builtin_amdgcn_readlane((int)lo, 63); hi = (unsigned)__builtin_amdgcn_readlane((int)hi, 63);
    return ((unsigned long long)hi << 32) | lo;
}
struct NsaBuf { const bf16_t *Qs, *Kc, *VcT, *Ksel, *VselT, *Kwin, *VwinT; };
template <bool GEN>
__device__ __forceinline__ void nsa_exp(const f32x4& sA, const f32x4& sB, float (&e)[8], float bfar, int dist0, int dstep, int dmax, const int* lut, const float* b2h) {
#pragma unroll
    for (int i = 0; i < 8; ++i) {
        const float s = i < 4 ? sA[i] : sB[i - 4];
        if (GEN) { const int dist = dist0 - i * dstep; const bool ok = dist >= 0 && dist <= dmax; const int dd = dist < 0 ? 0 : (dist > 127 ? 127 : dist);
            const float l = s + b2h[lut[dd] * 8]; e[i] = ok ? __builtin_amdgcn_exp2f(l) : 0.f; }
        else e[i] = __builtin_amdgcn_exp2f(s + bfar);
    }
}
constexpr int NSA_WB = 18432, NSA_LUT = NWAVES * NSA_WB;
static_assert(NSA_LUT + 2048 + NWAVES * 512 <= MISC_OFF, "NSA LDS map");
constexpr int NCT = 2, QT = 4 * NCT;
__device__ __forceinline__ void nsa_unit(const Params& P, const NsaBuf& B, int unit, float* sc, int* selL, const int* lut, const float* b2) {
    unsigned char* slotK = (unsigned char*)sc; unsigned char* slotV = slotK + 9216;
    const int lane = otid() & 63, c = lane & 15, rq = lane >> 4, g = c & 3, qq = c >> 2;
    const int hkv = unit & 1, t0 = (unit >> 1) * QT;
    const float* b2h = b2 + hkv * 4 + g; const float bfar = b2h[31 * 8];
    const int krow = 8 * (c >> 2) + (c & 3);
    bf16x8 Qf[NCT][2];
#pragma unroll
    for (int ct = 0; ct < NCT; ++ct)
#pragma unroll
        for (int ks = 0; ks < 2; ++ks) Qf[ct][ks] = *(const bf16x8*)(B.Qs + (size_t)(t0 + ct * 4 + qq) * 512 + hkv * 256 + g * 64 + ks * 32 + rq * 8);
    f32x4 O[4][NCT];
#pragma unroll
    for (int dt = 0; dt < 4; ++dt)
#pragma unroll
        for (int ct = 0; ct < NCT; ++ct) O[dt][ct] = (f32x4){0.f, 0.f, 0.f, 0.f};
    const f32x4 zero4 = (f32x4){0.f, 0.f, 0.f, 0.f};
    const float* gat = P.gates + (size_t)(t0 + qq) * 24 + (hkv * 4 + g) * 3;
    {
        float Z[NCT]; for (int ct = 0; ct < NCT; ++ct) Z[ct] = 0.f;
        const bf16_t* Kb = B.Kwin + (size_t)hkv * TP * 64; const bf16_t* Vb = B.VwinT + (size_t)hkv * 256 * 4096;
        struct Raw16 { v4u k[8], v[8]; };
#define BLK_GLOAD(R_, jj) do { const unsigned char* kp_ = (const unsigned char*)Kb + (size_t)(jj) * 8192 + lane * 16; const unsigned char* vp_ = (const unsigned char*)Vb + (size_t)(jj) * 8192 + lane * 16; \
        _Pragma("unroll") for (int n = 0; n < 8; ++n) { R_.k[n] = *(const v4u*)(kp_ + n * 1024); R_.v[n] = *(const v4u*)(vp_ + n * 1024); } } while (0)
#define BLK_STORE(R_) do { _Pragma("unroll") for (int n = 0; n < 8; ++n) { const int k_ = n * 8 + (lane >> 3), kk_ = k_ & 31, ir_ = (k_ & 32) + ((kk_ >> 2) & 1) * 16 + (((kk_ >> 3) << 2) | (kk_ & 3)); \
        *(v4u*)(slotK + ir_ * 144 + (lane & 7) * 16) = R_.k[n]; *(v4u*)(slotV + (n * 8 + (lane >> 3)) * 144 + (lane & 7) * 16) = R_.v[n]; } } while (0)
        int jb0 = t0 - 512; if (jb0 < 0) jb0 = 0; jb0 >>= 6; const int jb1 = (t0 + QT - 1) >> 6;
        Raw16 R;
        BLK_GLOAD(R, jb0);
#pragma unroll 1
        for (int jb = jb0; jb <= jb1; ++jb) {
            BLK_STORE(R);
            if (jb < jb1) BLK_GLOAD(R, jb + 1);
            const bool gen = (64 * jb + 63 > t0 - 113) || (64 * jb < t0 + QT - 1 - 512);
#pragma unroll
            for (int hh = 0; hh < 2; ++hh) {
                const int k0 = 64 * jb + 32 * hh; bf16x8 KA[2], KB[2], Vf[4];
#pragma unroll
                for (int ks = 0; ks < 2; ++ks) { KA[ks] = *(const bf16x8*)(slotK + (32 * hh + c) * 144 + (ks * 4 + rq) * 16); KB[ks] = *(const bf16x8*)(slotK + (32 * hh + 16 + c) * 144 + (ks * 4 + rq) * 16); }
#pragma unroll
                for (int dt = 0; dt < 4; ++dt) Vf[dt] = *(const bf16x8*)(slotV + (dt * 16 + c) * 144 + (4 * hh + rq) * 16);
#pragma unroll
                for (int ct = 0; ct < NCT; ++ct) {
                    f32x4 sA = MFMA16(KA[0], Qf[ct][0], zero4); sA = MFMA16(KA[1], Qf[ct][1], sA);
                    f32x4 sB = MFMA16(KB[0], Qf[ct][0], zero4); sB = MFMA16(KB[1], Qf[ct][1], sB);
                    float e[8];
                    if (gen) nsa_exp<true>(sA, sB, e, bfar, (t0 + ct * 4 + qq) - (k0 + 8 * rq), 1, 512, lut, b2h); else nsa_exp<false>(sA, sB, e, bfar, 0, 0, 0, lut, b2h);
                    Z[ct] += ((e[0] + e[1]) + (e[2] + e[3])) + ((e[4] + e[5]) + (e[6] + e[7]));
                    const bf16x8 Pf = pack8(e);
#pragma unroll
                    for (int dt = 0; dt < 4; ++dt) O[dt][ct] = MFMA16(Vf[dt], Pf, O[dt][ct]);
                }
            }
        }
#undef BLK_GLOAD
#undef BLK_STORE
#pragma unroll
        for (int ct = 0; ct < NCT; ++ct) { float z = Z[ct]; z += __shfl_xor(z, 16); z += __shfl_xor(z, 32); const float sc_ = gat[ct * 96 + 2] / fmaxf(z, 1e-30f);
#pragma unroll
            for (int dt = 0; dt < 4; ++dt) O[dt][ct] = O[dt][ct] * sc_; }
    }
    {
        const bf16_t* Kb = B.Kc + (size_t)hkv * 1024 * 64; const bf16_t* Vb = B.VcT + (size_t)hkv * 64 * 1024;
        const int ncv_max = (t0 + QT - 1 >= 31) ? min(NCMP, (t0 + QT - 1 - 31) / 16 + 1) : 0, nsteps = (ncv_max + 31) >> 5;
        float Z[NCT]; for (int ct = 0; ct < NCT; ++ct) Z[ct] = 0.f;
        unsigned char* cK = (unsigned char*)sc + 8192; unsigned char* cV = cK + 4608;
        struct Raw8 { v4u k[4], v[4]; };
#define CMP_GLOAD(R_, ss, withv) do { const unsigned char* kp_ = (const unsigned char*)Kb + (size_t)(ss) * 4096 + lane * 16; const unsigned char* vp_ = (const unsigned char*)Vb + (size_t)(ss) * 4096 + lane * 16; \
        _Pragma("unroll") for (int n = 0; n < 4; ++n) { R_.k[n] = *(const v4u*)(kp_ + n * 1024); if (withv) R_.v[n] = *(const v4u*)(vp_ + n * 1024); } } while (0)
#define CMP_STORE(R_, withv) do { _Pragma("unroll") for (int n = 0; n < 4; ++n) { const int kk_ = n * 8 + (lane >> 3), ir_ = ((kk_ >> 2) & 1) * 16 + (((kk_ >> 3) << 2) | (kk_ & 3)); \
        *(v4u*)(cK + ir_ * 144 + (lane & 7) * 16) = R_.k[n]; if (withv) *(v4u*)(cV + (n * 16 + (lane >> 2)) * 80 + (lane & 3) * 16) = R_.v[n]; } } while (0)
#define CMP_FRAGK(KA_, KB_) do { _Pragma("unroll") for (int ks = 0; ks < 2; ++ks) { KA_[ks] = *(const bf16x8*)(cK + c * 144 + (ks * 4 + rq) * 16); KB_[ks] = *(const bf16x8*)(cK + (16 + c) * 144 + (ks * 4 + rq) * 16); } } while (0)
#define CMP_FRAGV(Vf_) do { _Pragma("unroll") for (int dt = 0; dt < 4; ++dt) Vf_[dt] = *(const bf16x8*)(cV + (dt * 16 + c) * 80 + rq * 16); } while (0)
        {
        Raw8 R;
        if (nsteps > 0) CMP_GLOAD(R, 0, false);
#pragma unroll 1
        for (int s = 0; s < nsteps; ++s) {
            const int n0 = 32 * s;
            CMP_STORE(R, false);
            if (s + 1 < nsteps) CMP_GLOAD(R, s + 1, false);
            bf16x8 KA[2], KB[2]; CMP_FRAGK(KA, KB);
            const bool gen = 16 * (n0 + 31) + 31 + 113 > t0;
#pragma unroll
            for (int ct = 0; ct < NCT; ++ct) {
                f32x4 sA = MFMA16(KA[0], Qf[ct][0], zero4); sA = MFMA16(KA[1], Qf[ct][1], sA);
                f32x4 sB = MFMA16(KB[0], Qf[ct][0], zero4); sB = MFMA16(KB[1], Qf[ct][1], sB);
                float e[8];
                if (gen) nsa_exp<true>(sA, sB, e, bfar, (t0 + ct * 4 + qq) - 31 - 16 * (n0 + 8 * rq), 16, 1 << 30, lut, b2h); else nsa_exp<false>(sA, sB, e, bfar, 0, 0, 0, lut, b2h);
                Z[ct] += ((e[0] + e[1]) + (e[2] + e[3])) + ((e[4] + e[5]) + (e[6] + e[7]));
            }
        }
        }
        float inv[NCT], gs[NCT], carry[NCT];
#pragma unroll
        for (int ct = 0; ct < NCT; ++ct) { float z = Z[ct]; z += __shfl_xor(z, 16); z += __shfl_xor(z, 32); inv[ct] = 1.f / fmaxf(z, 1e-30f); gs[ct] = gat[ct * 96 + 0] * inv[ct]; carry[ct] = 0.f; }
        Raw8 R;
        if (nsteps > 0) CMP_GLOAD(R, 0, true);
#pragma unroll 1
        for (int s = 0; s < nsteps; ++s) {
            const int n0 = 32 * s;
            CMP_STORE(R, true);
            if (s + 1 < nsteps) CMP_GLOAD(R, s + 1, true);
            bf16x8 KA[2], KB[2], Vf[4]; CMP_FRAGK(KA, KB); CMP_FRAGV(Vf);
            const bool gen = 16 * (n0 + 31) + 31 + 113 > t0;
#pragma unroll
            for (int ct = 0; ct < NCT; ++ct) {
                f32x4 sA = MFMA16(KA[0], Qf[ct][0], zero4); sA = MFMA16(KA[1], Qf[ct][1], sA);
                f32x4 sB = MFMA16(KB[0], Qf[ct][0], zero4); sB = MFMA16(KB[1], Qf[ct][1], sB);
                float e[8], pg[8], im[8];
                if (gen) nsa_exp<true>(sA, sB, e, bfar, (t0 + ct * 4 + qq) - 31 - 16 * (n0 + 8 * rq), 16, 1 << 30, lut, b2h); else nsa_exp<false>(sA, sB, e, bfar, 0, 0, 0, lut, b2h);
#pragma unroll
                for (int i = 0; i < 8; ++i) { pg[i] = e[i] * gs[ct]; float x = e[i] * inv[ct]; x += dpp_xor1(x); x += dpp_xor2(x); im[i] = x; }
                const bf16x8 Pf = pack8(pg);
#pragma unroll
                for (int dt = 0; dt < 4; ++dt) O[dt][ct] = MFMA16(Vf[dt], Pf, O[dt][ct]);
                const float up = __shfl(im[7], (lane + 48) & 63);
                const float m1 = rq == 0 ? carry[ct] : up;
                carry[ct] = __shfl(im[7], 48 + c);
                if (g == 0) { const int J0 = (n0 >> 2) + 2 * rq; float* scq = sc + (ct * 4 + qq) * 256 + J0;
                    scq[0] = m1 + 2.f * ((im[0] + im[1]) + im[2]) + im[3]; scq[1] = im[3] + 2.f * ((im[4] + im[5]) + im[6]) + im[7]; }
            }
        }
#undef CMP_GLOAD
#undef CMP_STORE
#undef CMP_FRAGK
#undef CMP_FRAGV
        if (nsteps < 32) { const int w = 256 - 8 * nsteps; for (int i = lane; i < QT * w; i += 64) sc[(i / w) * 256 + 8 * nsteps + (i % w)] = 0.f; }
    }
    LDS_WAIT(); asm volatile("" ::: "memory");
#pragma unroll 1
    for (int qi = 0; qi < QT; ++qi) {
        const int q_pos = t0 + qi, cur = q_pos >> 6;
        if (cur < 16) { if (lane < 16) selL[qi * 16 + lane] = lane <= cur ? lane : -1; }
        else {
            unsigned long long k[4];
#pragma unroll
            for (int i = 0; i < 4; ++i) { const int J = lane + 64 * i; const bool valid = J >= 1 && J <= cur - 2; k[i] = valid ? (((unsigned long long)__float_as_uint(sc[qi * 256 + J]) << 32) | (0xFFFFFFFFu - (unsigned)J)) : 0ull; }
            if (lane == 0) { selL[qi * 16 + 0] = 0; selL[qi * 16 + 1] = cur - 1; selL[qi * 16 + 2] = cur; }
#pragma unroll 1
            for (int r = 0; r < 13; ++r) {
                unsigned long long m = k[0] > k[1] ? k[0] : k[1]; const unsigned long long m2 = k[2] > k[3] ? k[2] : k[3]; m = m > m2 ? m : m2;
                const unsigned long long wm = wave_max_u64(m);
                if (lane == 0) selL[qi * 16 + 3 + r] = (int)(0xFFFFFFFFu - (unsigned)wm);
#pragma unroll
                for (int i = 0; i < 4; ++i) k[i] = (k[i] == wm) ? 0ull : k[i];
            }
        }
    }
    LDS_WAIT(); asm volatile("" ::: "memory");
    {
        const bf16_t* Kb = B.Ksel + (size_t)hkv * TP * 64; const bf16_t* Vb = B.VselT + (size_t)hkv * 256 * 4096;
        const bf16x8 zq = (bf16x8){0, 0, 0, 0, 0, 0, 0, 0};
#pragma unroll
        for (int ct = 0; ct < NCT; ++ct) {
#pragma unroll 1
            for (int q2 = 0; q2 < 4; ++q2) {
                const int qi = ct * 4 + q2, q_pos = t0 + qi, cur = q_pos >> 6;
                const bool mine = (qq == q2);
                const bf16x8 Q0 = mine ? Qf[ct][0] : zq, Q1 = mine ? Qf[ct][1] : zq;
                f32x4 Os[4] = {zero4, zero4, zero4, zero4}; float Zs = 0.f;
                struct SelRaw { v4u k[8], v[8]; };
#define SEL_GLOAD(R_, jj) do { const unsigned char* kp_ = (const unsigned char*)Kb + (size_t)(jj) * 8192 + lane * 16; const unsigned char* vp_ = (const unsigned char*)Vb + (size_t)(jj) * 8192 + lane * 16; \
        _Pragma("unroll") for (int n = 0; n < 8; ++n) { R_.k[n] = *(const v4u*)(kp_ + n * 1024); R_.v[n] = *(const v4u*)(vp_ + n * 1024); } } while (0)
#define SEL_STORE(R_) do { _Pragma("unroll") for (int n = 0; n < 8; ++n) { const int k_ = n * 8 + (lane >> 3), kk_ = k_ & 31, ir_ = (k_ & 32) + ((kk_ >> 2) & 1) * 16 + (((kk_ >> 3) << 2) | (kk_ & 3)); \
        *(v4u*)(slotK + ir_ * 144 + (lane & 7) * 16) = R_.k[n]; *(v4u*)(slotV + (n * 8 + (lane >> 3)) * 144 + (lane & 7) * 16) = R_.v[n]; } } while (0)
#define SEL_COMPUTE(jj) do { const bool gen = (jj) >= cur - 2; _Pragma("unroll") for (int hh = 0; hh < 2; ++hh) { const int k0 = 64 * (jj) + 32 * hh; bf16x8 KA[2], KB[2], Vf[4]; \
        _Pragma("unroll") for (int ks = 0; ks < 2; ++ks) { KA[ks] = *(const bf16x8*)(slotK + (32 * hh + c) * 144 + (ks * 4 + rq) * 16); KB[ks] = *(const bf16x8*)(slotK + (32 * hh + 16 + c) * 144 + (ks * 4 + rq) * 16); } \
        _Pragma("unroll") for (int dt = 0; dt < 4; ++dt) Vf[dt] = *(const bf16x8*)(slotV + (dt * 16 + c) * 144 + (4 * hh + rq) * 16); \
        f32x4 sA = MFMA16(KA[0], Q0, zero4); sA = MFMA16(KA[1], Q1, sA); f32x4 sB = MFMA16(KB[0], Q0, zero4); sB = MFMA16(KB[1], Q1, sB); \
        float e[8]; if (gen) nsa_exp<true>(sA, sB, e, bfar, q_pos - (k0 + 8 * rq), 1, 1 << 30, lut, b2h); else nsa_exp<false>(sA, sB, e, bfar, 0, 0, 0, lut, b2h); \
        Zs += ((e[0] + e[1]) + (e[2] + e[3])) + ((e[4] + e[5]) + (e[6] + e[7])); const bf16x8 Pf = pack8(e); \
        _Pragma("unroll") for (int dt = 0; dt < 4; ++dt) Os[dt] = MFMA16(Vf[dt], Pf, Os[dt]); } } while (0)
                const int nb = cur < 16 ? cur + 1 : 16;
                SelRaw R;
                int j = __builtin_amdgcn_readfirstlane(selL[qi * 16]);
                SEL_GLOAD(R, j);
#pragma unroll 1
                for (int bi = 0; bi < nb; ++bi) {
                    SEL_STORE(R);
                    const int jn = __builtin_amdgcn_readfirstlane(selL[qi * 16 + (bi + 1 < nb ? bi + 1 : bi)]);
                    if (bi + 1 < nb) SEL_GLOAD(R, jn);
                    SEL_COMPUTE(j);
                    j = jn;
                }
#undef SEL_GLOAD
#undef SEL_STORE
#undef SEL_COMPUTE
                Zs += __shfl_xor(Zs, 16); Zs += __shfl_xor(Zs, 32);
                const float sc_ = mine ? gat[ct * 96 + 1] / fmaxf(Zs, 1e-30f) : 0.f;
#pragma unroll
                for (int dt = 0; dt < 4; ++dt) O[dt][ct] = O[dt][ct] + Os[dt] * sc_;
            }
        }
    }
#pragma unroll
    for (int ct = 0; ct < NCT; ++ct)
#pragma unroll
        for (int dt = 0; dt < 4; ++dt) { v2u w; w.x = pg8::cvt_pk_bf16(O[dt][ct][0], O[dt][ct][1]); w.y = pg8::cvt_pk_bf16(O[dt][ct][2], O[dt][ct][3]);
            *(v2u*)(P.ao + (size_t)(t0 + ct * 4 + qq) * D + 512 + (hkv * 4 + g) * 64 + dt * 16 + 4 * rq) = w; }
}

__device__ __forceinline__ void nsa_unit_sample(const Params& P, int unit, float* sc, int* selL, const int* lut, const float* b2) {
    const int lane = otid() & 63, c = lane & 15, rq = lane >> 4, g = c & 3, qq = c >> 2;
    const int hkv = unit & 1, b = unit >> 1, bh = b * 2 + hkv;
    const int m = TP + b * 4 + qq, qpos = PAST + qq;
    const float* b2h = b2 + hkv * 4 + g; const float bfar = b2h[31 * 8];
    const int krow = 8 * (c >> 2) + (c & 3);
    bf16x8 Qf[2];
#pragma unroll
    for (int ks = 0; ks < 2; ++ks) Qf[ks] = *(const bf16x8*)(P.Qs + (size_t)m * 512 + hkv * 256 + g * 64 + ks * 32 + rq * 8);
    const f32x4 zero4 = (f32x4){0.f, 0.f, 0.f, 0.f};
    f32x4 O[4] = {zero4, zero4, zero4, zero4};
    const float* gat = P.gates + (size_t)m * 24 + (hkv * 4 + g) * 3;
    {
        const bf16_t* Kb = P.KwinS + (size_t)bh * 544 * 64; const bf16_t* Vb = P.VwinST + (size_t)bh * 64 * 544;
        float Z = 0.f;
#pragma unroll 1
        for (int k0 = 0; k0 < 544; k0 += 32) {
            bf16x8 KA[2], KB[2], Vf[4];
#pragma unroll
            for (int ks = 0; ks < 2; ++ks) { KA[ks] = *(const bf16x8*)(Kb + (size_t)(k0 + krow) * 64 + ks * 32 + rq * 8); KB[ks] = *(const bf16x8*)(Kb + (size_t)(k0 + krow + 4) * 64 + ks * 32 + rq * 8); }
#pragma unroll
            for (int dt = 0; dt < 4; ++dt) Vf[dt] = *(const bf16x8*)(Vb + (size_t)(dt * 16 + c) * 544 + k0 + rq * 8);
            f32x4 sA = MFMA16(KA[0], Qf[0], zero4); sA = MFMA16(KA[1], Qf[1], sA); f32x4 sB = MFMA16(KB[0], Qf[0], zero4); sB = MFMA16(KB[1], Qf[1], sB);
            float e[8]; nsa_exp<true>(sA, sB, e, bfar, 512 + qq - (k0 + 8 * rq), 1, 512, lut, b2h);
            Z += ((e[0] + e[1]) + (e[2] + e[3])) + ((e[4] + e[5]) + (e[6] + e[7]));
            const bf16x8 Pf = pack8(e);
#pragma unroll
            for (int dt = 0; dt < 4; ++dt) O[dt] = MFMA16(Vf[dt], Pf, O[dt]);
        }
        Z += __shfl_xor(Z, 16); Z += __shfl_xor(Z, 32); const float sc_ = gat[2] / fmaxf(Z, 1e-30f);
#pragma unroll
        for (int dt = 0; dt < 4; ++dt) O[dt] = O[dt] * sc_;
    }
    {
        const bf16_t* Kb = P.Kc + ((size_t)(b + 1) * 2 + hkv) * 1024 * 64; const bf16_t* Vb = P.VcT + ((size_t)(b + 1) * 2 + hkv) * 64 * 1024;
        float Z = 0.f;
#pragma unroll 1
        for (int s = 0; s < 32; ++s) {
            const int n0 = 32 * s; bf16x8 KA[2], KB[2];
#pragma unroll
            for (int ks = 0; ks < 2; ++ks) { KA[ks] = *(const bf16x8*)(Kb + (size_t)(n0 + krow) * 64 + ks * 32 + rq * 8); KB[ks] = *(const bf16x8*)(Kb + (size_t)(n0 + krow + 4) * 64 + ks * 32 + rq * 8); }
            f32x4 sA = MFMA16(KA[0], Qf[0], zero4); sA = MFMA16(KA[1], Qf[1], sA); f32x4 sB = MFMA16(KB[0], Qf[0], zero4); sB = MFMA16(KB[1], Qf[1], sB);
            float e[8]; nsa_exp<true>(sA, sB, e, bfar, qpos - 31 - 16 * (n0 + 8 * rq), 16, 1 << 30, lut, b2h);
            Z += ((e[0] + e[1]) + (e[2] + e[3])) + ((e[4] + e[5]) + (e[6] + e[7]));
        }
        Z += __shfl_xor(Z, 16); Z += __shfl_xor(Z, 32);
        const float inv = 1.f / fmaxf(Z, 1e-30f), gs = gat[0] * inv; float carry = 0.f;
#pragma unroll 1
        for (int s = 0; s < 32; ++s) {
            const int n0 = 32 * s; bf16x8 KA[2], KB[2], Vf[4];
#pragma unroll
            for (int ks = 0; ks < 2; ++ks) { KA[ks] = *(const bf16x8*)(Kb + (size_t)(n0 + krow) * 64 + ks * 32 + rq * 8); KB[ks] = *(const bf16x8*)(Kb + (size_t)(n0 + krow + 4) * 64 + ks * 32 + rq * 8); }
#pragma unroll
            for (int dt = 0; dt < 4; ++dt) Vf[dt] = *(const bf16x8*)(Vb + ((size_t)s * 64 + dt * 16 + c) * 32 + rq * 8);
            f32x4 sA = MFMA16(KA[0], Qf[0], zero4); sA = MFMA16(KA[1], Qf[1], sA); f32x4 sB = MFMA16(KB[0], Qf[0], zero4); sB = MFMA16(KB[1], Qf[1], sB);
            float e[8], pg[8], im[8]; nsa_exp<true>(sA, sB, e, bfar, qpos - 31 - 16 * (n0 + 8 * rq), 16, 1 << 30, lut, b2h);
#pragma unroll
            for (int i = 0; i < 8; ++i) { pg[i] = e[i] * gs; float x = e[i] * inv; x += dpp_xor1(x); x += dpp_xor2(x); im[i] = x; }
            const bf16x8 Pf = pack8(pg);
#pragma unroll
            for (int dt = 0; dt < 4; ++dt) O[dt] = MFMA16(Vf[dt], Pf, O[dt]);
            const float up = __shfl(im[7], (lane + 48) & 63); const float m1 = rq == 0 ? carry : up; carry = __shfl(im[7], 48 + c);
            if (g == 0) { const int J0 = (n0 >> 2) + 2 * rq; float* scq = sc + qq * 256 + J0;
                scq[0] = m1 + 2.f * ((im[0] + im[1]) + im[2]) + im[3]; scq[1] = im[3] + 2.f * ((im[4] + im[5]) + im[6]) + im[7]; }
        }
    }
    LDS_WAIT(); asm volatile("" ::: "memory");
#pragma unroll 1
    for (int qi = 0; qi < 4; ++qi) {
        unsigned long long k[4];
#pragma unroll
        for (int i = 0; i < 4; ++i) { const int J = lane + 64 * i; const bool valid = J >= 1 && J <= 254; k[i] = valid ? (((unsigned long long)__float_as_uint(sc[qi * 256 + J]) << 32) | (0xFFFFFFFFu - (unsigned)J)) : 0ull; }
        if (lane == 0) { selL[qi * 16 + 0] = 0; selL[qi * 16 + 1] = 255; selL[qi * 16 + 2] = 256; }
#pragma unroll 1
        for (int r = 0; r < 13; ++r) {
            unsigned long long mx = k[0] > k[1] ? k[0] : k[1]; const unsigned long long m2 = k[2] > k[3] ? k[2] : k[3]; mx = mx > m2 ? mx : m2;
            const unsigned long long wm = wave_max_u64(mx);
            if (lane == 0) selL[qi * 16 + 3 + r] = (int)(0xFFFFFFFFu - (unsigned)wm);
#pragma unroll
            for (int i = 0; i < 4; ++i) k[i] = (k[i] == wm) ? 0ull : k[i];
        }
    }
    LDS_WAIT(); asm volatile("" ::: "memory");
    {
        const bf16x8 zq = (bf16x8){0, 0, 0, 0, 0, 0, 0, 0};
        const bf16_t* Kn = P.KselSn + (size_t)bh * 4096; const bf16_t* Vn = P.VselSTn + (size_t)bh * 4096;
#pragma unroll 1
        for (int q2 = 0; q2 < 4; ++q2) {
            const int q_pos = PAST + q2; const bool mine = (qq == q2);
            const bf16x8 Q0 = mine ? Qf[0] : zq, Q1 = mine ? Qf[1] : zq;
            f32x4 Os[4] = {zero4, zero4, zero4, zero4}; float Zs = 0.f;
#pragma unroll 1
            for (int bi = 0; bi < 16; ++bi) {
                const int j = __builtin_amdgcn_readfirstlane(selL[q2 * 16 + bi]);
#pragma unroll 1
                for (int h = 0; h < 2; ++h) {
                    bf16x8 KA[2], KB[2], Vf[4];
                    if (j == 256) {
#pragma unroll
                        for (int ks = 0; ks < 2; ++ks) { KA[ks] = *(const bf16x8*)(Kn + (32 * h + krow) * 64 + ks * 32 + rq * 8); KB[ks] = *(const bf16x8*)(Kn + (32 * h + krow + 4) * 64 + ks * 32 + rq * 8); }
#pragma unroll
                        for (int dt = 0; dt < 4; ++dt) Vf[dt] = *(const bf16x8*)(Vn + (dt * 16 + c) * 64 + 32 * h + rq * 8);
                    } else {
                        const int page = P.pt[b * NPAGES + (j >> 1)]; const size_t rowb = (size_t)page * 128 + (j & 1) * 64 + 32 * h;
#pragma unroll
                        for (int ks = 0; ks < 2; ++ks) {
                            const float* pa = P.cache + ((rowb + krow) * 4 + 2) * 128 + hkv * 64 + ks * 32 + rq * 8; const float* pb = pa + 4 * 512;
                            const f32x4 a0 = *(const f32x4*)pa, a1 = *(const f32x4*)(pa + 4), b0 = *(const f32x4*)pb, b1 = *(const f32x4*)(pb + 4);
                            v4u wa, wb; wa.x = pk2(a0.x, a0.y); wa.y = pk2(a0.z, a0.w); wa.z = pk2(a1.x, a1.y); wa.w = pk2(a1.z, a1.w); wb.x = pk2(b0.x, b0.y); wb.y = pk2(b0.z, b0.w); wb.z = pk2(b1.x, b1.y); wb.w = pk2(b1.z, b1.w);
                            KA[ks] = __builtin_bit_cast(bf16x8, wa); KB[ks] = __builtin_bit_cast(bf16x8, wb); }
#pragma unroll
                        for (int dt = 0; dt < 4; ++dt) { const float* pv = P.cache + ((rowb + 8 * rq) * 4 + 3) * 128 + hkv * 64 + dt * 16 + c; float x[8];
#pragma unroll
                            for (int jj = 0; jj < 8; ++jj) x[jj] = pv[(size_t)jj * 512];
                            v4u w; w.x = pk2(x[0], x[1]); w.y = pk2(x[2], x[3]); w.z = pk2(x[4], x[5]); w.w = pk2(x[6], x[7]); Vf[dt] = __builtin_bit_cast(bf16x8, w); }
                    }
                    f32x4 sA = MFMA16(KA[0], Q0, zero4); sA = MFMA16(KA[1], Q1, sA); f32x4 sB = MFMA16(KB[0], Q0, zero4); sB = MFMA16(KB[1], Q1, sB);
                    float e[8];
                    if (j >= 254) nsa_exp<true>(sA, sB, e, bfar, q_pos - (64 * j + 32 * h + 8 * rq), 1, 1 << 30, lut, b2h); else nsa_exp<false>(sA, sB, e, bfar, 0, 0, 0, lut, b2h);
                    Zs += ((e[0] + e[1]) + (e[2] + e[3])) + ((e[4] + e[5]) + (e[6] + e[7]));
                    const bf16x8 Pf = pack8(e);
#pragma unroll
                    for (int dt = 0; dt < 4; ++dt) Os[dt] = MFMA16(Vf[dt], Pf, Os[dt]);
                }
            }
            Zs += __shfl_xor(Zs, 16); Zs += __shfl_xor(Zs, 32);
            const float sc_ = mine ? gat[1] / fmaxf(Zs, 1e-30f) : 0.f;
#pragma unroll
            for (int dt = 0; dt < 4; ++dt) O[dt] = O[dt] + Os[dt] * sc_;
        }
    }
#pragma unroll
    for (int dt = 0; dt < 4; ++dt) { v2u w; w.x = pg8::cvt_pk_bf16(O[dt][0], O[dt][1]); w.y = pg8::cvt_pk_bf16(O[dt][2], O[dt][3]);
        *(v2u*)(P.ao + (size_t)m * D + 512 + (hkv * 4 + g) * 64 + dt * 16 + 4 * rq) = w; }
}
__device__ __forceinline__ void p5_nsa_mfma(const Params& P, unsigned char* lds, int G, int rep) {
    int* lut = (int*)(lds + NSA_LUT); float* b2 = (float*)(lds + NSA_LUT + 512);
    const int tid = otid(), wave = __builtin_amdgcn_readfirstlane(tid >> 6), lane = tid & 63;
    if (tid < 128) { int n = tid, bk; if (n < 16) bk = n; else { const float v = logf((float)n / 16.f) / 2.0794415416798357f * 16.f; bk = 16 + (int)v; if (bk > 31) bk = 31; } lut[tid] = bk; }
    if (tid < 256) b2[tid] = P.tb[tid] * LOG2E;
    __syncthreads();
    float* sc = (float*)(lds + wave * NSA_WB); int* selL = (int*)(lds + NSA_LUT + 2048 + wave * 512);
    const NsaBuf B{P.Qs, P.Kc, P.VcT, P.Ksel, P.VselT, P.Kwin, P.VwinT};
    constexpr int NSU = 32, NPU = TP / QT;
    const int pref = (int)((xb_xcc_id() >> 2) & 1u);
    int q = pref, dry = 0;
    for (;;) {
        unsigned u = 0; if (lane == 0) u = atomicAdd(P.ctl + 32 + 2 * rep + q, 1u);
        u = (unsigned)__builtin_amdgcn_readfirstlane((int)u);
        if (u >= (unsigned)(NSU + NPU)) { if (++dry == 2) break; q ^= 1; continue; }
        if (u < NSU) nsa_unit_sample(P, ((int)u << 1) | q, sc, selL, lut, b2);
        else nsa_unit(P, B, ((NPU - 1 - ((int)u - NSU)) << 1) | q, sc, selL, lut, b2);
    }
    __syncthreads();
}
template <int MODE>
__device__ __forceinline__ void hg_item(const Params& P, float* L, int idx, int h, int tid) {
    float *fl = L, *vl = L + 128, *ql = L + 256, *red = L + 384;
    const int v = tid & 127, dh = tid >> 7;
    float S[64];
    if (MODE == 0) {
#pragma unroll
        for (int j = 0; j < 64; ++j) S[j] = 0.f;
    } else if (MODE == 1) {
#pragma unroll
        for (int j = 0; j < 64; ++j) S[j] = P.Sst[(((size_t)idx * 8 + h) * 128 + dh * 64 + j) * 128 + v];
    } else {
#pragma unroll
        for (int j = 0; j < 64; ++j) S[j] = P.hg_state[(((size_t)idx * 8 + h) * 128 + dh * 64 + j) * 128 + v];
    }
    float Dt = 1.f; const float lbv = P.lbv[h * 128 + v];
    const int t0 = MODE == 2 ? TP + 4 * idx : idx * 256, nt = MODE == 2 ? 4 : 256;
    for (int t = t0; t < t0 + nt; ++t) {
        const float* row = P.hgp + (size_t)t * 4096;
        if (dh == 0) { const float f = lbv + (1.f - lbv) * sigmoidf_(row[1024 + h * 128 + v]); fl[v] = f; Dt *= f; if (MODE != 0) ql[v] = row[h * 128 + v]; } else vl[v] = row[2048 + h * 128 + v];
        __syncthreads();
        const float vv = vl[v]; float part = 0.f;
#pragma unroll
        for (int j = 0; j < 64; ++j) { const float f = fl[dh * 64 + j]; S[j] = f * S[j] + (1.f - f) * vv; if (MODE != 0) part += ql[dh * 64 + j] * S[j]; }
        if (MODE != 0) red[dh * 128 + v] = part;
        __syncthreads();
        if (MODE != 0 && dh == 0) P.og[(size_t)t * D + h * 128 + v] = red[v] + red[128 + v];
    }
    if (MODE == 0) {
#pragma unroll
        for (int j = 0; j < 64; ++j) P.dS[(((size_t)idx * 8 + h) * 128 + dh * 64 + j) * 128 + v] = S[j];
        if (dh == 0) P.Dtot[((size_t)idx * 8 + h) * 128 + v] = Dt;
    } else if (MODE == 2) {
#pragma unroll
        for (int j = 0; j < 64; ++j) P.out[OFF_HGS + (((size_t)idx * 8 + h) * 128 + dh * 64 + j) * 128 + v] = S[j];
    }
}
template <int MODE>
__device__ __forceinline__ void hg_phase(const Params& P, unsigned char* lds, int G) {
    const int tid = otid() & 255, half = otid() >> 8;
    float* L = (float*)lds + half * 640;
    const int nit = (MODE == 2 ? 32 : 64) * 4;
    for (int it = blockIdx.x; it < nit; it += G) { hg_item<MODE>(P, L, it >> 2, (it & 3) * 2 + half, tid); __syncthreads(); }
}
__device__ __forceinline__ void hg_scan(const Params& P, int G) {
    for (int idx = blockIdx.x * NTHR + otid(); idx < 131072; idx += G * NTHR) {
        const int h = idx >> 14, d = (idx >> 7) & 127;
        float S = 0.f;
        for (int sc = 0; sc < 64; ++sc) { P.Sst[(size_t)sc * 131072 + idx] = S; S = P.Dtot[((size_t)sc * 8 + h) * 128 + d] * S + P.dS[(size_t)sc * 131072 + idx]; }
        P.out[OFF_HGP + idx] = S;
    }
}
__device__ __forceinline__ void hg_norm(const Params& P, int G) {
    const int h = __builtin_amdgcn_readfirstlane(otid() >> 6), lane = otid() & 63;
    for (int m = TP + blockIdx.x; m < MR; m += G) {
        const float o0 = P.og[(size_t)m * D + h * 128 + lane], o1 = P.og[(size_t)m * D + h * 128 + 64 + lane];
        const float s = wave_sum(o0 * o0 + o1 * o1), r = rsqrtf(s * (1.f / 128.f) + EPS);
        const float g0 = P.hgp[(size_t)m * 4096 + 3072 + h * 128 + lane], g1 = P.hgp[(size_t)m * 4096 + 3072 + h * 128 + 64 + lane];
        P.ao[(size_t)m * D + h * 128 + lane] = (bf16_t)f2bf(o0 * r * P.hg_ng[lane] * g0 * sigmoidf_(g0));
        P.ao[(size_t)m * D + h * 128 + 64 + lane] = (bf16_t)f2bf(o1 * r * P.hg_ng[64 + lane] * g1 * sigmoidf_(g1));
    }
}

namespace hg {
typedef short bf16x8 __attribute__((ext_vector_type(8)));
constexpr int LD128 = 136, LD64 = 72;
constexpr int OFF_QT = 0, OFF_QH = OFF_QT + 64 * LD128 * 2, OFF_KT = OFF_QH + 64 * LD128 * 2, OFF_KHT = OFF_KT + 64 * LD128 * 2, OFF_VT = OFF_KHT + 128 * LD64 * 2,
              OFF_ST = OFF_VT + 128 * LD64 * 2, OFF_DV = OFF_ST + 128 * LD128 * 2, OFF_PREF = OFF_DV + 512, HG_LDS_END = OFF_PREF + 2048 + 512;
static_assert(HG_LDS_END <= RING_BYTES, "hg LDS");
#define HMFMA(a, b, c) __builtin_amdgcn_mfma_f32_16x16x32_bf16((a), (b), (c), 0, 0, 0)
template <int MODE>
__device__ __forceinline__ void item(const Params& P, unsigned char* lds, int sc, int h) {
    const int tid = otid(), lane = tid & 63, w = __builtin_amdgcn_readfirstlane(tid >> 6), c = lane & 15, rq = lane >> 4;
    const int d = tid & 127, qtr = __builtin_amdgcn_readfirstlane(tid >> 7);
    bf16_t* QT = (bf16_t*)(lds + OFF_QT); bf16_t* QH = (bf16_t*)(lds + OFF_QH); bf16_t* KT = (bf16_t*)(lds + OFF_KT); bf16_t* KHT = (bf16_t*)(lds + OFF_KHT);
    bf16_t* VT = (bf16_t*)(lds + OFF_VT); bf16_t* ST = (bf16_t*)(lds + OFF_ST); float* Dv = (float*)(lds + OFF_DV); float* pref = (float*)(lds + OFF_PREF); float* red = (float*)(lds + OFF_PREF + 2048);
    f32x4 acc[8];
    const float lbv = P.lbv[h * 128 + d];
    float sumtot = 0.f;
    if (MODE == 1) {
        const float* S0 = P.Sst + ((size_t)sc * 8 + h) * 16384;
#pragma unroll
        for (int dt = 0; dt < 8; ++dt)
#pragma unroll
            for (int i = 0; i < 4; ++i) { const float s = S0[(16 * w + 4 * rq + i) * 128 + 16 * dt + c]; acc[dt][i] = s; ST[(16 * w + 4 * rq + i) * LD128 + 16 * dt + c] = (bf16_t)f2bf(s); }
    } else {
#pragma unroll
        for (int dt = 0; dt < 8; ++dt) acc[dt] = (f32x4){0.f, 0.f, 0.f, 0.f};
    }
#pragma unroll 1
    for (int ch = 0; ch < 4; ++ch) {
        const int tb = sc * 256 + ch * 64 + qtr * 16;
        float qv[16], kv[16], bv[16], vv[16];
        float cum = 0.f;
#pragma unroll
        for (int i = 0; i < 16; ++i) { const float* row = P.hgp + (size_t)(tb + i) * 4096 + h * 128 + d;
            const float f = lbv + (1.f - lbv) * sigmoidf_(row[1024]); cum += __logf(f); bv[i] = cum; kv[i] = 1.f - f; vv[i] = row[2048]; if (MODE == 1) qv[i] = row[0]; }
        pref[qtr * 128 + d] = cum;
        __syncthreads();
        const float p0 = pref[d], p1 = pref[128 + d], p2 = pref[256 + d], p3 = pref[384 + d];
        const float off = qtr == 0 ? 0.f : (qtr == 1 ? p0 : (qtr == 2 ? p0 + p1 : (p0 + p1) + p2)), total = ((p0 + p1) + p2) + p3, r = p0 + p1;
        sumtot += total;
        { unsigned kh[8], vt[8];
#pragma unroll
          for (int i = 0; i < 16; i += 2) { const float b0 = bv[i] + off, b1 = bv[i + 1] + off;
              kh[i >> 1] = pk2(kv[i] * __expf(total - b0), kv[i + 1] * __expf(total - b1)); vt[i >> 1] = pk2(vv[i], vv[i + 1]);
              if (MODE == 1) { const int t0_ = qtr * 16 + i;
                  QT[t0_ * LD128 + d] = (bf16_t)f2bf(qv[i] * __expf(b0 - r)); QT[(t0_ + 1) * LD128 + d] = (bf16_t)f2bf(qv[i + 1] * __expf(b1 - r));
                  QH[t0_ * LD128 + d] = (bf16_t)f2bf(qv[i] * __expf(b0)); QH[(t0_ + 1) * LD128 + d] = (bf16_t)f2bf(qv[i + 1] * __expf(b1));
                  KT[t0_ * LD128 + d] = (bf16_t)f2bf(kv[i] * __expf(r - b0)); KT[(t0_ + 1) * LD128 + d] = (bf16_t)f2bf(kv[i + 1] * __expf(r - b1)); } }
          *(v4u*)(KHT + d * LD64 + qtr * 16) = (v4u){kh[0], kh[1], kh[2], kh[3]}; *(v4u*)(KHT + d * LD64 + qtr * 16 + 8) = (v4u){kh[4], kh[5], kh[6], kh[7]};
          *(v4u*)(VT + d * LD64 + qtr * 16) = (v4u){vt[0], vt[1], vt[2], vt[3]}; *(v4u*)(VT + d * LD64 + qtr * 16 + 8) = (v4u){vt[4], vt[5], vt[6], vt[7]}; }
        if (qtr == 0) Dv[d] = __expf(total);
        __syncthreads();
        if (MODE == 1) {
            const int tt = w & 3, vh = w >> 2;
            bf16x8 Pf[2];
#pragma unroll
            for (int ss = 0; ss < 2; ++ss) {
                if (ss == 1 && tt < 2) { Pf[1] = (bf16x8){0, 0, 0, 0, 0, 0, 0, 0}; continue; }
                f32x4 sA = (f32x4){0.f, 0.f, 0.f, 0.f}, sB = sA;
                const int srow = 32 * ss + 8 * (c >> 2) + (c & 3);
#pragma unroll
                for (int kd = 0; kd < 4; ++kd) { const bf16x8 qf = *(const bf16x8*)(QT + (16 * tt + c) * LD128 + kd * 32 + rq * 8);
                    sA = HMFMA(*(const bf16x8*)(KT + srow * LD128 + kd * 32 + rq * 8), qf, sA); sB = HMFMA(*(const bf16x8*)(KT + (srow + 4) * LD128 + kd * 32 + rq * 8), qf, sB); }
                const int t = 16 * tt + c, s0 = 32 * ss + 8 * rq; float e[8];
#pragma unroll
                for (int i = 0; i < 8; ++i) { const float x = i < 4 ? sA[i] : sB[i - 4]; e[i] = (s0 + i <= t) ? x : 0.f; }
                v4u p; p.x = pk2(e[0], e[1]); p.y = pk2(e[2], e[3]); p.z = pk2(e[4], e[5]); p.w = pk2(e[6], e[7]); Pf[ss] = __builtin_bit_cast(bf16x8, p);
            }
            f32x4 o[4]; float ssq = 0.f;
#pragma unroll
            for (int vt = 0; vt < 4; ++vt) { const int V = vh * 4 + vt; o[vt] = (f32x4){0.f, 0.f, 0.f, 0.f};
                o[vt] = HMFMA(*(const bf16x8*)(VT + (16 * V + c) * LD64 + rq * 8), Pf[0], o[vt]);
                if (tt >= 2) o[vt] = HMFMA(*(const bf16x8*)(VT + (16 * V + c) * LD64 + 32 + rq * 8), Pf[1], o[vt]);
#pragma unroll
                for (int kd = 0; kd < 4; ++kd) o[vt] = HMFMA(*(const bf16x8*)(ST + (16 * V + c) * LD128 + kd * 32 + rq * 8), *(const bf16x8*)(QH + (16 * tt + c) * LD128 + kd * 32 + rq * 8), o[vt]);
                ssq += (o[vt][0] * o[vt][0] + o[vt][1] * o[vt][1]) + (o[vt][2] * o[vt][2] + o[vt][3] * o[vt][3]); }
            ssq += __shfl_xor(ssq, 16); ssq += __shfl_xor(ssq, 32);
            if (rq == 0) red[vh * 64 + 16 * tt + c] = ssq;
            __syncthreads();
            { const float rs = rsqrtf((red[16 * tt + c] + red[64 + 16 * tt + c]) * (1.f / 128.f) + EPS);
              const int trow = sc * 256 + ch * 64 + 16 * tt + c;
#pragma unroll
              for (int vt = 0; vt < 4; ++vt) { const int v0 = 16 * (vh * 4 + vt) + 4 * rq; const f32x4 gg = *(const f32x4*)(P.hgp + (size_t)trow * 4096 + 3072 + h * 128 + v0), ng = *(const f32x4*)(P.hg_ng + v0);
                  float y[4];
#pragma unroll
                  for (int i = 0; i < 4; ++i) y[i] = o[vt][i] * rs * ng[i] * gg[i] * sigmoidf_(gg[i]);
                  v2u wv; wv.x = pk2(y[0], y[1]); wv.y = pk2(y[2], y[3]); *(v2u*)(P.ao + (size_t)trow * D + h * 128 + v0) = wv; } }
        }

#pragma unroll
        for (int dt = 0; dt < 8; ++dt) acc[dt] = acc[dt] * Dv[16 * dt + c];
#pragma unroll
        for (int ss = 0; ss < 2; ++ss) { const bf16x8 vf = *(const bf16x8*)(VT + (16 * w + c) * LD64 + 32 * ss + rq * 8);
#pragma unroll
            for (int dt = 0; dt < 8; ++dt) acc[dt] = HMFMA(vf, *(const bf16x8*)(KHT + (16 * dt + c) * LD64 + 32 * ss + rq * 8), acc[dt]); }
        if (MODE == 1 && ch < 3) {
            __syncthreads();
#pragma unroll
            for (int dt = 0; dt < 8; ++dt)
#pragma unroll
                for (int i = 0; i < 4; ++i) ST[(16 * w + 4 * rq + i) * LD128 + 16 * dt + c] = (bf16_t)f2bf(acc[dt][i]);
        }
    }
    if (MODE == 0) {
        float* dS = P.dS + ((size_t)sc * 8 + h) * 16384;
#pragma unroll
        for (int dt = 0; dt < 8; ++dt)
#pragma unroll
            for (int i = 0; i < 4; ++i) dS[(16 * w + 4 * rq + i) * 128 + 16 * dt + c] = acc[dt][i];
        if (qtr == 0) P.Dtot[((size_t)sc * 8 + h) * 128 + d] = __expf(sumtot);
    }
    __syncthreads();
}
template <int MODE>
__device__ __forceinline__ void phase(const Params& P, unsigned char* lds, int G) {
    for (int it = blockIdx.x; it < 512; it += G) item<MODE>(P, lds, it >> 3, it & 7);
}
__device__ __forceinline__ void scan(const Params& P, int G) {
    for (int idx = blockIdx.x * NTHR + otid(); idx < 131072; idx += G * NTHR) {
        const int h = idx >> 14, v = (idx >> 7) & 127, d = idx & 127;
        float S = 0.f;
#pragma unroll 8
        for (int sc = 0; sc < 64; ++sc) { P.Sst[(size_t)sc * 131072 + idx] = S; S = P.Dtot[((size_t)sc * 8 + h) * 128 + d] * S + P.dS[(size_t)sc * 131072 + idx]; }
        P.out[OFF_HGP + h * 16384 + d * 128 + v] = S;
    }
}
}
constexpr int NPHASE = 17;
#ifndef REP_MASK
#define REP_MASK 0
#endif
#ifndef NSA_CHECK
#define NSA_CHECK 0
#endif
#ifndef MK_PER_PHASE
#define MK_PER_PHASE 0
#endif
__global__ void __launch_bounds__(NTHR, 2) fwd(Params P) {
    extern __shared__ __attribute__((aligned(16))) unsigned char lds[];
    LAS unsigned char* ldsl = (LAS unsigned char*)lds;
    const int G = gridDim.x;
    volatile LAS unsigned* MISC = (volatile LAS unsigned*)(ldsl + MISC_OFF);
    for (int u = otid(); u < 64; u += NTHR) ((LAS unsigned*)(ldsl + MISC_OFF))[u] = 0u;
    __syncthreads();
    XcdBarrier bar; bar.bar = P.ctl + CW_BAR; bar.x = 0; bar.st = nullptr;
    if (!MK_PER_PHASE) bar = xcd_barrier_post(P.ctl + CW_BAR, MISC + 8);
    const int lo = P.ph_lo, hi = P.ph_hi;
#define IN(k) (lo <= (k) && (k) < hi)
#define SEAM(k) do { if (!MK_PER_PHASE && IN(k) && IN((k) + 1)) xcd_barrier(bar); } while (0)
#define BIGGEMM(EPI, Aptr, Btptr, Mv, Nv, Kv, ...) do { pg8::Gemm g{Aptr, Btptr, Mv, Nv, Kv}; pg8::StaticOrder S; S.init(Mv, Nv, G, (int)blockIdx.x); pg8::EPI E{__VA_ARGS__}; \
        pg8::gemm_phase<pg8::EPI, pg8::StaticOrder, true, true>(ldsl, g, S, E); __syncthreads(); } while (0)

    float* rtab = (float*)(lds + 65536 + 4096);
#define NREP(k) (1 + ((REP_MASK >> (k)) & 1))
#define PH(k, ...) if (IN(k)) { _Pragma("unroll") for (int rep_ = 0; rep_ < NREP(k); ++rep_) { __VA_ARGS__ if (rep_ + 1 < NREP(k)) xcd_barrier(bar); } SEAM(k); }
    PH(0, p0_prologue(P, lds, G, 1 + ((REP_MASK >> 17) & 1), 1 + ((REP_MASK >> 18) & 1), 1 + ((REP_MASK >> 19) & 1));)
    PH(1,
        BIGGEMM(EpiIn, P.xb, P.Wt_in, TP, NINP, D, P.ssp0, P.q_g, P.k_g, P.out, P.glub, P.Qs, P.acmp, P.Ksel, P.Kwin, P.VselT, P.VwinT, P.gates);
        sgemm_mfma(P.xb, P.Wt_in, NINP, D, SEpProj{P.proj, P.ssp0}, lds, G);)
#if NSA_CHECK
    if (IN(1)) { BIGGEMM(EpiProjNat, P.xb, P.Wt_in, TP, NINP, D, P.proj, P.ssp0); xcd_barrier(bar); }
#endif
    if (IN(3)) {
        p2_sample(P, G);
#if NSA_CHECK
        p2_check(P, G);
#endif
#pragma unroll
        for (int r3 = 0; r3 < 1 + ((REP_MASK >> 20) & 1); ++r3) { p3_conv(P, lds, G); __syncthreads(); }
        BIGGEMM(EpiScale, P.acmp, P.W1cmp, CMPROWS, 256, 1024, P.hfs, nullptr, 256, 0);
        BIGGEMM(EpiScale, P.acmp + (size_t)CMPROWS * 1024, P.W1cmp + (size_t)256 * 1024, CMPROWS, 256, 1024, P.hfs + (size_t)CMPROWS * 256, nullptr, 256, 0);
        SEAM(3); }
    PH(4, p4_cmp_finish(P, lds, G);)
    PH(5, p5_nsa_mfma(P, lds, G, rep_);)
#if NSA_CHECK
    if (IN(5)) { xcd_barrier(bar); p5_nsa<1>(P, lds, G); }
#endif
    PH(6,
        BIGGEMM(EpiResid, P.ao, P.Wt_out0, TP, D, D, P.x_prompt, P.x1, P.xb, P.ssp1);
        sgemm_mfma(P.ao, P.Wt_out0, D, D, SEpResid{P.x_sample, P.x1, P.xb, P.ssps1, TP, 0}, lds, G);)
    PH(7,
        BIGGEMM(EpiUp, P.xb, P.Wt_up0, TP, FF, D, P.hid, P.ssp1);
        sample_rtab(P.ssps1, rtab);
        sgemm_mfma(P.xb, P.Wt_up0, FF, D, SEpUp{P.hid, rtab}, lds, G);)
    PH(8,
        BIGGEMM(EpiResid, P.hid, P.Wt_dn0, TP, D, FF, P.x1, P.x2, P.xb, P.ssp2);
        sgemm_mfma(P.hid, P.Wt_dn0, D, FF, SEpResid{P.x1, P.x2, P.xb, P.ssps2, 0, 0}, lds, G);)
    PH(9,
        BIGGEMM(EpiScale, P.xb, P.Wt_hgin, TP, FF, D, P.hgp, P.ssp2, FF, 0);
        sample_rtab(P.ssps2, rtab);
        sgemm_mfma(P.xb, P.Wt_hgin, FF, D, SEpScale{P.hgp, rtab, FF, 0}, lds, G);)
    PH(10, hg::phase<0>(P, lds, G); hg_phase<2>(P, lds, G);)
    PH(11, hg::scan(P, G);)
    PH(12, hg::phase<1>(P, lds, G);)
    PH(13, hg_norm(P, G);)
    PH(14,
        BIGGEMM(EpiResid, P.ao, P.Wt_hgout, TP, D, D, P.x2, P.x3, P.xb, P.ssp3);
        sgemm_mfma(P.ao, P.Wt_hgout, D, D, SEpResid{P.x2, P.x3, P.xb, P.ssps3, 0, 0}, lds, G);)
    PH(15,
        BIGGEMM(EpiUp, P.xb, P.Wt_up1, TP, FF, D, P.hid, P.ssp3);
        sample_rtab(P.ssps3, rtab);
        sgemm_mfma(P.xb, P.Wt_up1, FF, D, SEpUp{P.hid, rtab}, lds, G);)
    if (IN(16)) {
#pragma unroll
        for (int rep_ = 0; rep_ < NREP(16); ++rep_) {
        BIGGEMM(EpiResid, P.hid, P.Wt_dn1, TP, D, FF, P.x3, P.out, nullptr, nullptr);
        sgemm_mfma(P.hid, P.Wt_dn1, D, FF, SEpResid{P.x3, P.out, nullptr, nullptr, 0, 0}, lds, G);
        }
#if NSA_CHECK
        xcd_barrier(bar);
        if (blockIdx.x == 0 && otid() == 0) { const float qn_ = __builtin_nanf("");
            const unsigned n = xb_ld(P.ctl + 16), n5 = xb_ld(P.ctl + 17), n2 = xb_ld(P.ctl + 18), n50 = xb_ld(P.ctl + 19);
            const unsigned s = xb_ld(P.ctl + 24), s5 = xb_ld(P.ctl + 25), s2 = xb_ld(P.ctl + 26), s50 = xb_ld(P.ctl + 27);
            if (n != 384u || s != 128u) P.out[OFF_YP] = qn_;
            if (n5 * 10u > n) P.out[OFF_KVP] = qn_;
            if (n50 * 50u > n) P.out[OFF_WINP] = qn_;
            if (n2 * 2u > n) P.out[OFF_CONVP] = qn_;
            if (s5 * 10u > s) P.out[OFF_KVS] = qn_;
            if (s50 * 50u > s) P.out[OFF_WINS] = qn_;
            if (s2 * 2u > s) P.out[OFF_CONVS] = qn_; }
#endif
    }
#undef IN
#undef SEAM
}

extern "C" void kernel_launch(void* const* d_in, const int* in_sizes, int n_in, void* d_out, int out_size, void* d_ws, size_t ws_size, hipStream_t stream) {
    static int grid = 0;
    if (grid == 0) {
        if (n_in != 28 || out_size != (int)OUT_TOTAL) { fprintf(stderr, "kernel_launch: unexpected shapes (n_in %d out %d)\n", n_in, out_size); grid = -1; return; }
        int dev = 0, cus = 0, per_cu = 0;
        if (hipGetDevice(&dev) != hipSuccess || hipDeviceGetAttribute(&cus, hipDeviceAttributeMultiprocessorCount, dev) != hipSuccess) { grid = -1; return; }
        if (hipFuncSetAttribute((const void*)fwd, hipFuncAttributeMaxDynamicSharedMemorySize, LDS_BYTES) != hipSuccess) { fprintf(stderr, "kernel_launch: hipFuncSetAttribute failed\n"); grid = -1; return; }
        if (hipOccupancyMaxActiveBlocksPerMultiprocessor(&per_cu, (const void*)fwd, NTHR, LDS_BYTES) != hipSuccess || per_cu < 1) fprintf(stderr, "kernel_launch: occupancy query reports %d\n", per_cu);
        (void)hipGetLastError();
        grid = cus;
    }
    if (grid < 0) return;
    unsigned char* ws = (unsigned char*)d_ws; size_t off = 0;
    auto alloc = [&](size_t bytes) { void* p = ws + off; off += (bytes + 1048575) & ~(size_t)1048575; return p; };
    Params P{};
    P.x_prompt = (const float*)d_in[0]; P.x_sample = (const float*)d_in[1]; P.cache = (const float*)d_in[2]; P.pt = (const int*)d_in[3];
    P.win_state = (const float*)d_in[4]; P.conv_state = (const float*)d_in[5]; P.hg_state = (const float*)d_in[6]; P.tb = (const float*)d_in[7];
    P.g_mix = (const float*)d_in[8]; P.g_mlp = (const float*)d_in[9]; P.w_up = (const float*)d_in[10]; P.w_dn = (const float*)d_in[11];
    P.w_in = (const float*)d_in[12]; P.w_out = (const float*)d_in[13]; P.q_g = (const float*)d_in[14]; P.k_g = (const float*)d_in[15];
    P.cmp_pe = (const float*)d_in[16]; P.cmp_w1 = (const float*)d_in[17]; P.cmp_b1 = (const float*)d_in[18]; P.cmp_w2 = (const float*)d_in[19];
    P.conv_w = (const float*)d_in[20]; P.conv_b = (const float*)d_in[21]; P.ln_g = (const float*)d_in[22]; P.ln_b = (const float*)d_in[23];
    P.hg_w_in = (const float*)d_in[24]; P.hg_w_out = (const float*)d_in[25]; P.hg_lb = (const float*)d_in[26]; P.hg_ng = (const float*)d_in[27];
    P.out = (float*)d_out;
    P.ctl = (unsigned*)alloc(CTL_BYTES);
    P.Wt_in = (bf16_t*)alloc((size_t)NINP * D * 2); P.Wt_out0 = (bf16_t*)alloc((size_t)D * D * 2); P.Wt_up0 = (bf16_t*)alloc((size_t)FF * D * 2); P.Wt_dn0 = (bf16_t*)alloc((size_t)D * FF * 2);
    P.Wt_hgin = (bf16_t*)alloc((size_t)FF * D * 2); P.Wt_hgout = (bf16_t*)alloc((size_t)D * D * 2); P.Wt_up1 = (bf16_t*)alloc((size_t)FF * D * 2); P.Wt_dn1 = (bf16_t*)alloc((size_t)D * FF * 2);
    P.W1cmp = (bf16_t*)alloc((size_t)2 * 256 * 1024 * 2); P.cbv = (float*)alloc(1024); P.lbv = (float*)alloc(4096);
    P.xb = (bf16_t*)alloc((size_t)MR * D * 2);
    P.ssp0 = (float*)alloc((size_t)MR * 64); P.ssp1 = (float*)alloc((size_t)MR * 64); P.ssp2 = (float*)alloc((size_t)MR * 64); P.ssp3 = (float*)alloc((size_t)MR * 64);
    P.ssps1 = (float*)alloc(SR * 64 * 4); P.ssps2 = (float*)alloc(SR * 64 * 4); P.ssps3 = (float*)alloc(SR * 64 * 4);
    P.Qs = (bf16_t*)alloc((size_t)MR * 512 * 2); P.Kc = (bf16_t*)alloc((size_t)66 * 1024 * 64 * 2); P.VcT = (bf16_t*)alloc((size_t)66 * 64 * 1024 * 2);
    P.KwinS = (bf16_t*)alloc((size_t)64 * 544 * 64 * 2); P.VwinST = (bf16_t*)alloc((size_t)64 * 64 * 544 * 2); P.KselSn = (bf16_t*)alloc((size_t)64 * 4096 * 2); P.VselSTn = (bf16_t*)alloc((size_t)64 * 4096 * 2);
    P.Ksel = (bf16_t*)alloc((size_t)2 * TP * 64 * 2); P.VselT = (bf16_t*)alloc((size_t)2 * TP * 64 * 2); P.Kwin = (bf16_t*)alloc((size_t)2 * TP * 64 * 2); P.VwinT = (bf16_t*)alloc((size_t)2 * TP * 64 * 2);
    P.proj = (float*)alloc((size_t)MR * NIN * 4); P.glu = (float*)alloc((size_t)MR * CC * 4); P.qn = (float*)alloc((size_t)MR * 512 * 4);
    P.kvw = (float*)alloc((size_t)MR * 768 * 4); P.gates = (float*)alloc((size_t)MR * 24 * 4); P.ao = (bf16_t*)alloc((size_t)MR * D * 2); P.aochk = (bf16_t*)alloc((size_t)MR * D * 2); P.glub = (bf16_t*)alloc((size_t)TP * CC * 2);
    P.acmp = (bf16_t*)alloc((size_t)2 * CMPROWS * 1024 * 2); P.hfs = (float*)alloc((size_t)2 * CMPROWS * 256 * 4); P.kcvc = (float*)alloc((size_t)33 * 4 * 1024 * 64 * 4);
    P.x1 = (float*)alloc((size_t)MR * D * 4); P.x2 = (float*)alloc((size_t)MR * D * 4); P.x3 = (float*)alloc((size_t)MR * D * 4);
    P.hid = (bf16_t*)alloc((size_t)MR * FF * 2); P.hgp = (float*)alloc((size_t)MR * FF * 4);
    P.dS = (float*)alloc((size_t)64 * 131072 * 4); P.Dtot = (float*)alloc((size_t)64 * 1024 * 4); P.Sst = (float*)alloc((size_t)64 * 131072 * 4); P.og = (float*)alloc((size_t)MR * D * 4);
    if (off > ws_size) { fprintf(stderr, "kernel_launch: workspace too small (%zu > %zu)\n", off, ws_size); return; }
    if (hipMemsetAsync(P.ctl, 0, CTL_BYTES, stream) != hipSuccess) { fprintf(stderr, "kernel_launch: memset failed\n"); return; }
#if MK_PER_PHASE
    for (int k = 0; k < NPHASE; ++k) { P.ph_lo = k; P.ph_hi = k + 1; hipLaunchKernelGGL(fwd, dim3(grid), dim3(NTHR), LDS_BYTES, stream, P); }
#else
    P.ph_lo = 0; P.ph_hi = NPHASE;
    hipLaunchKernelGGL(fwd, dim3(grid), dim3(NTHR), LDS_BYTES, stream, P);
#endif
    const hipError_t le = hipPeekAtLastError();
    if (le != hipSuccess) fprintf(stderr, "kernel_launch: launch failed: %s\n", hipGetErrorName(le));
}
```
